# Optimizing an MI355X kernel written in HIP

```python
import jax, jax.numpy as jnp
from jax import lax
import numpy as np

D_MODEL = 1024
BATCH = 4
SEQ = 4096
DEPTH = 1

N_ATT_HEADS = 8
HEAD_DIM = 64
ATT_WIDTH = N_ATT_HEADS * HEAD_DIM
Q_BLOCK = 128
CONV_WIDTH = 512
CONV_K = 3
N_GROUPS = 4
EXPERTS_PER_GROUP = 4
N_EXPERTS = N_GROUPS * EXPERTS_PER_GROUP
TOP_K_IN_GROUP = 2
D_EXPERT = 256
PLE_DIM = 256
EPS = 1e-6
NEG_INF = -1e30

PROJ_SIZES = (ATT_WIDTH, ATT_WIDTH, ATT_WIDTH, N_ATT_HEADS,
              CONV_WIDTH, CONV_WIDTH, CONV_WIDTH, D_MODEL, D_MODEL)
PROJ_WIDTH = 3 * ATT_WIDTH + N_ATT_HEADS + 3 * CONV_WIDTH + 2 * D_MODEL

kernel_name = "hybrid_fox_shortconv_hmoe_block"


def rms_norm(x, g):
    xf = x.astype(jnp.float32)
    y = xf * lax.rsqrt(jnp.mean(xf * xf, axis=-1, keepdims=True) + EPS)
    return (y * g.astype(jnp.float32)).astype(x.dtype)


def split_offsets():
    offs, acc = [], 0
    for s in PROJ_SIZES[:-1]:
        acc += s
        offs.append(acc)
    return offs


def forgetting_attention(q, k, v, log_f):
    b, s, h, d = q.shape
    n_blocks = s // Q_BLOCK
    c = jnp.cumsum(log_f, axis=1).transpose(0, 2, 1)
    qh = q.transpose(0, 2, 1, 3)
    kh = k.transpose(0, 2, 1, 3)
    vh = v.transpose(0, 2, 1, 3)
    q_blocks = jnp.moveaxis(qh.reshape(b, h, n_blocks, Q_BLOCK, d), 2, 0)
    c_blocks = jnp.moveaxis(c.reshape(b, h, n_blocks, Q_BLOCK), 2, 0)
    key_pos = jnp.arange(s)
    scale = HEAD_DIM ** -0.5

    def one_block(args):
        qb, cqb, blk = args
        q_pos = blk * Q_BLOCK + jnp.arange(Q_BLOCK)
        logits = jnp.einsum('bhqd,bhkd->bhqk', qb, kh).astype(jnp.float32) * scale
        logits = logits + (cqb[..., :, None] - c[..., None, :])
        causal = key_pos[None, :] <= q_pos[:, None]
        logits = jnp.where(causal, logits, NEG_INF)
        probs = jax.nn.softmax(logits, axis=-1)
        return jnp.einsum('bhqk,bhkd->bhqd', probs.astype(vh.dtype), vh)

    out = lax.map(one_block, (q_blocks, c_blocks, jnp.arange(n_blocks)))
    out = out.transpose(1, 0, 3, 2, 4).reshape(b, s, h * d)
    return out


def causal_short_conv(u, w):
    s = u.shape[1]
    u_pad = jnp.pad(u, ((0, 0), (CONV_K - 1, 0), (0, 0)))
    y = w[0] * u_pad[:, 0:s]
    for j in range(1, CONV_K):
        y = y + w[j] * u_pad[:, j:j + s]
    return y


def hierarchical_moe(h, w_rg, b_rg, w_re, b_re, w_gate, w_up, w_down):
    b, s, d = h.shape
    ht = h.reshape(b * s, d)
    g_logits = (ht @ w_rg + b_rg).astype(jnp.float32)
    g_prob = jax.nn.softmax(g_logits, axis=-1)
    g_val, g_idx = lax.top_k(g_prob, 1)
    e_logits = (ht @ w_re + b_re).astype(jnp.float32)
    e_logits = e_logits.reshape(-1, N_GROUPS, EXPERTS_PER_GROUP)
    e_in = jnp.take_along_axis(e_logits, g_idx[:, :, None], axis=1)[:, 0]
    e_prob = jax.nn.softmax(e_in, axis=-1)
    e_val, e_idx = lax.top_k(e_prob, TOP_K_IN_GROUP)
    e_val = e_val / jnp.sum(e_val, axis=-1, keepdims=True)
    gate = g_val * e_val
    global_idx = g_idx * EXPERTS_PER_GROUP + e_idx
    combine = jnp.sum(jax.nn.one_hot(global_idx, N_EXPERTS, dtype=jnp.float32)
                      * gate[..., None], axis=1)
    a = jnp.einsum('td,edf->tef', ht, w_gate)
    u = jnp.einsum('td,edf->tef', ht, w_up)
    hid = jax.nn.silu(a) * u * combine[..., None].astype(ht.dtype)
    out = jnp.einsum('tef,efd->td', hid, w_down)
    return out.reshape(b, s, d)


def setup_inputs(seed: int = 0) -> dict:
    key = jax.random.key(seed)
    ks = jax.random.split(key, 24)
    L, D = DEPTH, D_MODEL
    f32 = jnp.float32

    def nrm(k, shape, scale):
        return jax.random.normal(k, shape, f32) * scale

    def gain(k, shape):
        return 1.0 + 0.05 * jax.random.normal(k, shape, f32)

    return {
        "x": nrm(ks[0], (BATCH, SEQ, D), 1.0),
        "p": nrm(ks[1], (DEPTH, BATCH, SEQ, PLE_DIM), 1.0),
        "attn_norm_g": gain(ks[2], (L, D)),
        "w_in": nrm(ks[3], (L, D, PROJ_WIDTH), D ** -0.5),
        "b_f": 1.0 + 3.0 * jax.random.uniform(ks[4], (L, N_ATT_HEADS), f32),
        "q_norm_g": gain(ks[5], (L, HEAD_DIM)),
        "k_norm_g": gain(ks[6], (L, HEAD_DIM)),
        "conv_w": nrm(ks[7], (L, CONV_K, CONV_WIDTH), CONV_K ** -0.5),
        "w_out_att": nrm(ks[8], (L, ATT_WIDTH, D), ATT_WIDTH ** -0.5),
        "w_out_conv": nrm(ks[9], (L, CONV_WIDTH, D), CONV_WIDTH ** -0.5),
        "w_o": nrm(ks[10], (L, D, D), D ** -0.5),
        "ffn_norm_g": gain(ks[11], (L, D)),
        "w_rg": nrm(ks[12], (L, D, N_GROUPS), D ** -0.5),
        "b_rg": nrm(ks[13], (L, N_GROUPS), 0.01),
        "w_re": nrm(ks[14], (L, D, N_EXPERTS), D ** -0.5),
        "b_re": nrm(ks[15], (L, N_EXPERTS), 0.01),
        "w_gate": nrm(ks[16], (L, N_EXPERTS, D, D_EXPERT), D ** -0.5),
        "w_up": nrm(ks[17], (L, N_EXPERTS, D, D_EXPERT), D ** -0.5),
        "w_down": nrm(ks[18], (L, N_EXPERTS, D_EXPERT, D), D_EXPERT ** -0.5),
        "ple_norm_g": gain(ks[19], (L, D)),
        "w_pg": nrm(ks[20], (L, D, D), D ** -0.5),
        "w_ple": nrm(ks[21], (L, PLE_DIM, D), PLE_DIM ** -0.5),
    }


def reference(x, p, attn_norm_g, w_in, b_f, q_norm_g, k_norm_g, conv_w, w_out_att,
              w_out_conv, w_o, ffn_norm_g, w_rg, b_rg, w_re, b_re, w_gate, w_up, w_down,
              ple_norm_g, w_pg, w_ple):
    b, s, _ = x.shape
    offs = split_offsets()
    for i in range(DEPTH):
        h = rms_norm(x, attn_norm_g[i])
        proj = h @ w_in[i]
        q, k, v, f_logit, cb, cc, cu, ga, gb = jnp.split(proj, offs, axis=-1)

        q = rms_norm(q.reshape(b, s, N_ATT_HEADS, HEAD_DIM), q_norm_g[i])
        k = rms_norm(k.reshape(b, s, N_ATT_HEADS, HEAD_DIM), k_norm_g[i])
        v = v.reshape(b, s, N_ATT_HEADS, HEAD_DIM)
        log_f = jax.nn.log_sigmoid(f_logit.astype(jnp.float32) + b_f[i].astype(jnp.float32))
        y_att = forgetting_attention(q, k, v, log_f)

        y_conv = cb * causal_short_conv(cc * cu, conv_w[i])

        merged = (jax.nn.sigmoid(ga) * (y_att @ w_out_att[i])
                  + jax.nn.sigmoid(gb) * (y_conv @ w_out_conv[i]))
        x = x + merged @ w_o[i]

        h2 = rms_norm(x, ffn_norm_g[i])
        x = x + hierarchical_moe(h2, w_rg[i], b_rg[i], w_re[i], b_re[i],
                                 w_gate[i], w_up[i], w_down[i])

        h3 = rms_norm(x, ple_norm_g[i])
        x = x + jax.nn.sigmoid(h3 @ w_pg[i]) * (p[i] @ w_ple[i])
    return x
```

```cpp
#include <hip/hip_runtime.h>
#include <cstdint>
#include <cstdio>

namespace nv {
constexpr int D = 1024, B = 4, S = 4096, H = 8, HD = 64, AW = 512, CW = 512, PW = 5128;
constexpr int NG = 4, EPG = 4, NE = 16, DE = 256, PLE = 256;
constexpr float EPS = 1e-6f;
constexpr int OFF_Q = 0, OFF_K = 512, OFF_V = 1024, OFF_F = 1536, OFF_CB = 1544, OFF_CC = 2056, OFF_CU = 2568, OFF_GA = 3080, OFF_GB = 4104;

__device__ __forceinline__ float wsum(float v) {
#pragma unroll
    for (int o = 32; o > 0; o >>= 1) v += __shfl_xor(v, o);
    return v;
}
__device__ __forceinline__ float sigm(float x) { return 1.f / (1.f + expf(-x)); }

__global__ void rmsnorm1024(const float* __restrict__ x, const float* __restrict__ g, float* __restrict__ y, int rows) {
    const int w = (blockIdx.x * blockDim.x + threadIdx.x) >> 6, lane = threadIdx.x & 63;
    if (w >= rows) return;
    const float* xr = x + (size_t)w * D; float v[16]; float s = 0.f;
#pragma unroll
    for (int j = 0; j < 16; ++j) { v[j] = xr[lane + 64 * j]; s += v[j] * v[j]; }
    s = wsum(s); const float r = rsqrtf(s / D + EPS);
#pragma unroll
    for (int j = 0; j < 16; ++j) y[(size_t)w * D + lane + 64 * j] = v[j] * r * g[lane + 64 * j];
}

__global__ void __launch_bounds__(256) gemm_nn(const float* __restrict__ A, int lda, const float* __restrict__ Bm, int ldb, float* __restrict__ C, int ldc, int M, int N, int K) {
    __shared__ float As[16][64 + 1], Bs[16][64 + 1];
    const int tx = threadIdx.x & 15, ty = threadIdx.x >> 4, m0 = blockIdx.y * 64, n0 = blockIdx.x * 64;
    float acc[4][4] = {};
    for (int k0 = 0; k0 < K; k0 += 16) {
        for (int i = threadIdx.x; i < 64 * 16; i += 256) { const int m = i >> 4, k = i & 15; As[k][m] = (m0 + m < M) ? A[(size_t)(m0 + m) * lda + k0 + k] : 0.f; }
        for (int i = threadIdx.x; i < 64 * 16; i += 256) { const int k = i >> 6, n = i & 63; Bs[k][n] = (n0 + n < N) ? Bm[(size_t)(k0 + k) * ldb + n0 + n] : 0.f; }
        __syncthreads();
#pragma unroll
        for (int k = 0; k < 16; ++k) {
            float a[4], b[4];
#pragma unroll
            for (int i = 0; i < 4; ++i) { a[i] = As[k][ty * 4 + i]; b[i] = Bs[k][tx * 4 + i]; }
#pragma unroll
            for (int i = 0; i < 4; ++i)
#pragma unroll
                for (int j = 0; j < 4; ++j) acc[i][j] += a[i] * b[j];
        }
        __syncthreads();
    }
#pragma unroll
    for (int i = 0; i < 4; ++i)
#pragma unroll
        for (int j = 0; j < 4; ++j) { const int m = m0 + ty * 4 + i, n = n0 + tx * 4 + j; if (m < M && n < N) C[(size_t)m * ldc + n] = acc[i][j]; }
}

__global__ void qknorm(float* proj, const float* __restrict__ gq, const float* __restrict__ gk) {
    const int w = (blockIdx.x * blockDim.x + threadIdx.x) >> 6, lane = threadIdx.x & 63;
    if (w >= S * H * 2) return;
    const int which = w & 1, hh = (w >> 1) % H, t = (w >> 1) / H;
    float* p = proj + (size_t)t * PW + (which ? OFF_K : OFF_Q) + hh * HD;
    const float v = p[lane]; const float s = wsum(v * v);
    p[lane] = v * rsqrtf(s / HD + EPS) * (which ? gk[lane] : gq[lane]);
}
__global__ void fcumsum(const float* __restrict__ proj, const float* __restrict__ bf, float* __restrict__ c) {
    __shared__ float part[256];
    const int hh = blockIdx.x, tid = threadIdx.x; float v[16]; float s = 0.f;
#pragma unroll
    for (int j = 0; j < 16; ++j) { const int t = tid * 16 + j; const float z = proj[(size_t)t * PW + OFF_F + hh] + bf[hh];
        const float ls = fminf(z, 0.f) - log1pf(expf(-fabsf(z))); s += ls; v[j] = s; }
    part[tid] = s; __syncthreads();
    if (tid == 0) { float a = 0.f; for (int i = 0; i < 256; ++i) { const float x = part[i]; part[i] = a; a += x; } }
    __syncthreads();
    const float base = part[tid];
#pragma unroll
    for (int j = 0; j < 16; ++j) c[(size_t)hh * S + tid * 16 + j] = base + v[j];
}
__global__ void __launch_bounds__(128) fox_attn(const float* __restrict__ proj, const float* __restrict__ c, float* __restrict__ yatt) {
    __shared__ float Ks[32][64], Vs[32][64], Cs[32];
    const int hh = blockIdx.y, q0 = blockIdx.x * 128, tq = q0 + threadIdx.x;
    float q[64], o[64];
#pragma unroll
    for (int d = 0; d < 64; ++d) { q[d] = proj[(size_t)tq * PW + OFF_Q + hh * HD + d]; o[d] = 0.f; }
    const float cq = c[(size_t)hh * S + tq]; float m = -1e30f, l = 0.f;
    for (int k0 = 0; k0 < q0 + 128; k0 += 32) {
        __syncthreads();
        for (int i = threadIdx.x; i < 32 * 64; i += 128) { const int kk = i >> 6, d = i & 63; Ks[kk][d] = proj[(size_t)(k0 + kk) * PW + OFF_K + hh * HD + d]; Vs[kk][d] = proj[(size_t)(k0 + kk) * PW + OFF_V + hh * HD + d]; }
        if (threadIdx.x < 32) Cs[threadIdx.x] = c[(size_t)hh * S + k0 + threadIdx.x];
        __syncthreads();
        for (int kk = 0; kk < 32; ++kk) {
            if (k0 + kk > tq) break;
            float s = 0.f;
#pragma unroll
            for (int d = 0; d < 64; ++d) s += q[d] * Ks[kk][d];
            s = s * 0.125f + (cq - Cs[kk]);
            const float mn = fmaxf(m, s), a = expf(m - mn), p = expf(s - mn);
            l = l * a + p;
#pragma unroll
            for (int d = 0; d < 64; ++d) o[d] = o[d] * a + p * Vs[kk][d];
            m = mn;
        }
    }
    const float il = 1.f / l;
#pragma unroll
    for (int d = 0; d < 64; ++d) yatt[(size_t)tq * AW + hh * HD + d] = o[d] * il;
}
__global__ void convk(const float* __restrict__ proj, const float* __restrict__ cw, float* __restrict__ yc) {
    const int i = blockIdx.x * blockDim.x + threadIdx.x; if (i >= S * CW) return;
    const int t = i / CW, ch = i % CW; float y = 0.f;
#pragma unroll
    for (int j = 0; j < 3; ++j) { const int tt = t - 2 + j; if (tt >= 0) y += cw[j * CW + ch] * proj[(size_t)tt * PW + OFF_CC + ch] * proj[(size_t)tt * PW + OFF_CU + ch]; }
    yc[i] = proj[(size_t)t * PW + OFF_CB + ch] * y;
}
__global__ void mergek(const float* __restrict__ proj, const float* __restrict__ PA, const float* __restrict__ PB, float* __restrict__ mg) {
    const int i = blockIdx.x * blockDim.x + threadIdx.x; if (i >= S * D) return;
    const int t = i / D, n = i % D;
    mg[i] = sigm(proj[(size_t)t * PW + OFF_GA + n]) * PA[i] + sigm(proj[(size_t)t * PW + OFF_GB + n]) * PB[i];
}
__global__ void addk(const float* __restrict__ a, const float* __restrict__ b, float* __restrict__ o, int n) {
    const int i = blockIdx.x * blockDim.x + threadIdx.x; if (i < n) o[i] = a[i] + b[i];
}
__global__ void routek(const float* __restrict__ rl, const float* __restrict__ brg, const float* __restrict__ bre, int* __restrict__ sel, float* __restrict__ gw) {
    const int t = blockIdx.x * blockDim.x + threadIdx.x; if (t >= S) return;
    float gmax = -3e38f; int gi = 0;
#pragma unroll
    for (int i = 0; i < 4; ++i) { const float v = rl[t * 20 + i] + brg[i]; if (v > gmax) { gmax = v; gi = i; } }
    float gs = 0.f;
#pragma unroll
    for (int i = 0; i < 4; ++i) gs += expf(rl[t * 20 + i] + brg[i] - gmax);
    const float gval = 1.f / gs;
    float m0 = -3e38f, m1 = -3e38f; int i0 = 0, i1 = 0;
#pragma unroll
    for (int i = 0; i < 4; ++i) { const float v = rl[t * 20 + 4 + gi * 4 + i] + bre[gi * 4 + i];
        if (v > m0) { m1 = m0; i1 = i0; m0 = v; i0 = i; } else if (v > m1) { m1 = v; i1 = i; } }
    const float p1 = expf(m1 - m0); const float w0 = 1.f / (1.f + p1), w1 = p1 / (1.f + p1);
    sel[2 * t] = gi * 4 + i0; sel[2 * t + 1] = gi * 4 + i1; gw[2 * t] = gval * w0; gw[2 * t + 1] = gval * w1;
}
__global__ void __launch_bounds__(256) moek(const float* __restrict__ h2, const int* __restrict__ sel, const float* __restrict__ gw, const float* __restrict__ wg, const float* __restrict__ wu,
                                           const float* __restrict__ wd, float* xio) {
    __shared__ float hs[1024], hid[2][256];
    const int t = blockIdx.x, f = threadIdx.x;
    for (int i = f; i < 1024; i += 256) hs[i] = h2[(size_t)t * D + i];
    __syncthreads();
    for (int s = 0; s < 2; ++s) { const int e = sel[2 * t + s]; const float* G = wg + (size_t)e * D * DE; const float* U = wu + (size_t)e * D * DE; float a = 0.f, u = 0.f;
        for (int k = 0; k < 1024; ++k) { const float hv = hs[k]; a += hv * G[(size_t)k * DE + f]; u += hv * U[(size_t)k * DE + f]; }
        hid[s][f] = a * sigm(a) * u * gw[2 * t + s]; }
    __syncthreads();
    float o[4] = {0.f, 0.f, 0.f, 0.f};
    for (int s = 0; s < 2; ++s) { const int e = sel[2 * t + s]; const float* W = wd + (size_t)e * DE * D;
        for (int k = 0; k < 256; ++k) { const float hv = hid[s][k];
#pragma unroll
            for (int j = 0; j < 4; ++j) o[j] += hv * W[(size_t)k * D + f + 256 * j]; } }
#pragma unroll
    for (int j = 0; j < 4; ++j) xio[(size_t)t * D + f + 256 * j] += o[j];
}
__global__ void plek(const float* __restrict__ G, const float* __restrict__ U, float* xio, int n) {
    const int i = blockIdx.x * blockDim.x + threadIdx.x; if (i < n) xio[i] += sigm(G[i]) * U[i];
}
}

extern "C" void kernel_launch(void* const* d_in, const int* in_sizes, int n_in, void* d_out, int out_size, void* d_ws, size_t ws_size, hipStream_t stream) {
    using namespace nv;
    const float* x = (const float*)d_in[0]; const float* p = (const float*)d_in[1]; const float* g_attn = (const float*)d_in[2]; const float* w_in = (const float*)d_in[3];
    const float* b_f = (const float*)d_in[4]; const float* gq = (const float*)d_in[5]; const float* gk = (const float*)d_in[6]; const float* conv_w = (const float*)d_in[7];
    const float* w_oa = (const float*)d_in[8]; const float* w_oc = (const float*)d_in[9]; const float* w_o = (const float*)d_in[10]; const float* g_ffn = (const float*)d_in[11];
    const float* w_rg = (const float*)d_in[12]; const float* b_rg = (const float*)d_in[13]; const float* w_re = (const float*)d_in[14]; const float* b_re = (const float*)d_in[15];
    const float* w_gate = (const float*)d_in[16]; const float* w_up = (const float*)d_in[17]; const float* w_down = (const float*)d_in[18]; const float* g_ple = (const float*)d_in[19];
    const float* w_pg = (const float*)d_in[20]; const float* w_ple = (const float*)d_in[21];
    float* out = (float*)d_out; char* ws = (char*)d_ws;
    const size_t MiB = 1u << 20;
    float* hbuf = (float*)(ws + 0);
    float* proj = (float*)(ws + 16 * MiB);
    float* yatt = (float*)(ws + 100 * MiB);
    float* ycv = (float*)(ws + 108 * MiB);
    float* PA = (float*)(ws + 116 * MiB);
    float* PB = (float*)(ws + 132 * MiB);
    float* mg = (float*)(ws + 148 * MiB);
    float* tmp = (float*)(ws + 164 * MiB);
    float* cbuf = (float*)(ws + 180 * MiB);
    float* rl = (float*)(ws + 181 * MiB);
    int* sel = (int*)(ws + 182 * MiB); float* gwt = (float*)(ws + 183 * MiB);
    for (int b = 0; b < B; ++b) {
        const float* xb = x + (size_t)b * S * D; float* ob = out + (size_t)b * S * D; const float* pb = p + (size_t)b * S * PLE;
        rmsnorm1024<<<S / 4, 256, 0, stream>>>(xb, g_attn, hbuf, S);
        gemm_nn<<<dim3((PW + 63) / 64, S / 64), 256, 0, stream>>>(hbuf, D, w_in, PW, proj, PW, S, PW, D);
        qknorm<<<S * H * 2 / 4, 256, 0, stream>>>(proj, gq, gk);
        fcumsum<<<H, 256, 0, stream>>>(proj, b_f, cbuf);
        fox_attn<<<dim3(S / 128, H), 128, 0, stream>>>(proj, cbuf, yatt);
        convk<<<S * CW / 256, 256, 0, stream>>>(proj, conv_w, ycv);
        gemm_nn<<<dim3(D / 64, S / 64), 256, 0, stream>>>(yatt, AW, w_oa, D, PA, D, S, D, AW);
        gemm_nn<<<dim3(D / 64, S / 64), 256, 0, stream>>>(ycv, CW, w_oc, D, PB, D, S, D, CW);
        mergek<<<S * D / 256, 256, 0, stream>>>(proj, PA, PB, mg);
        gemm_nn<<<dim3(D / 64, S / 64), 256, 0, stream>>>(mg, D, w_o, D, tmp, D, S, D, D);
        addk<<<S * D / 256, 256, 0, stream>>>(xb, tmp, ob, S * D);
        rmsnorm1024<<<S / 4, 256, 0, stream>>>(ob, g_ffn, hbuf, S);
        gemm_nn<<<dim3(1, S / 64), 256, 0, stream>>>(hbuf, D, w_rg, NG, rl, 20, S, NG, D);
        gemm_nn<<<dim3(1, S / 64), 256, 0, stream>>>(hbuf, D, w_re, NE, rl + 4, 20, S, NE, D);
        routek<<<S / 256, 256, 0, stream>>>(rl, b_rg, b_re, sel, gwt);
        moek<<<S, 256, 0, stream>>>(hbuf, sel, gwt, w_gate, w_up, w_down, ob);
        rmsnorm1024<<<S / 4, 256, 0, stream>>>(ob, g_ple, hbuf, S);
        gemm_nn<<<dim3(D / 64, S / 64), 256, 0, stream>>>(hbuf, D, w_pg, D, PA, D, S, D, D);
        gemm_nn<<<dim3(D / 64, S / 64), 256, 0, stream>>>(pb, PLE, w_ple, D, PB, D, S, D, PLE);
        plek<<<S * D / 256, 256, 0, stream>>>(PA, PB, ob, S * D);
    }
}
```

```cpp
#ifndef CODE_PF_ENTRY
#define CODE_PF_ENTRY 0
#endif
#ifndef CODE_PF_EPI
#define CODE_PF_EPI 0
#endif
#ifndef CODE_PF
#define CODE_PF 2
#endif
#ifndef CODE_PF_SAFE
#define CODE_PF_SAFE (168u * 1024u)
#endif
#define CODE_PF_DUMP 139264
#include <hip/hip_runtime.h>
#include <hip/hip_bf16.h>
#include <cstdio>
#include <cstdint>
#include <cmath>

constexpr int DM_ = 1024, NB_ = 4, SEQ_ = 4096, NTOK = NB_ * SEQ_, NH_ = 8, HD_ = 64, AW_ = 512, CW_ = 512, PW_ = 5128;
constexpr int NE_ = 16, DE_ = 256, PLE_ = 256;
constexpr float EPS_ = 1e-6f;
constexpr int OFF_Q = 0, OFF_K = 512, OFF_V = 1024, OFF_F = 1536, OFF_CB = 1544, OFF_CC = 2056, OFF_CU = 2568, OFF_GA = 3080, OFF_GB = 4104;
constexpr float LOG2E = 1.4426950408889634f;
constexpr float QC2 = 0.125f * LOG2E;
constexpr int ECAP = NTOK;

__device__ __forceinline__ int lane_id() { int l; asm volatile("v_mbcnt_lo_u32_b32 %0, -1, 0\n\tv_mbcnt_hi_u32_b32 %0, -1, %0" : "=v"(l)); return l; }

namespace pg8 {
#define PG8_LAS __attribute__((address_space(3)))
typedef unsigned short bf16_t;
typedef short bf16x8 __attribute__((ext_vector_type(8)));
typedef float f32x4 __attribute__((ext_vector_type(4)));
typedef unsigned u32x4 __attribute__((ext_vector_type(4)));
typedef unsigned u32x2 __attribute__((ext_vector_type(2)));
constexpr int BM = 256, BK = 64, HALF = 128, HTB = HALF * BK * 2, STAGE_BYTES = 8 * HTB, NXCD = 8, WGM = 8;

__host__ __device__ __forceinline__ int lds_byte(int r, int c) { const int st = (r >> 4) * 2 + (c >> 5), rr = r & 15, cc = c & 31, ob = rr * 64 + cc * 2; return st * 1024 + (ob ^ (((ob >> 9) & 1) << 5)); }
__host__ __device__ __forceinline__ void stage_rc(int b, int& R, int& C) { const int st = b / 1024, sb = b % 1024, swz = sb ^ (((sb >> 9) & 1) << 5); R = (st >> 1) * 16 + swz / 64; C = (st & 1) * 32 + (swz % 64) / 2; }
__host__ __device__ __forceinline__ int g8(int row) { const int h = (row >> 1) & 7; return h ^ (((h >> 1) & 1) << 2); }
__host__ __device__ __forceinline__ int perm32(int rho) { const int n = rho >> 4, i = rho & 15; return 8 * (i >> 2) + 4 * n + (i & 3); }

struct Unit { int pm, pn; unsigned a; unsigned b; const int* rows; int nvalid; int e; int pos0; int chain; int rlo, rhi; unsigned zoff; };

struct StaticOrder {
    int nM, nN, nwg, G, c; unsigned A, Bt, tileA, tileB;
    __device__ void init(unsigned A_, unsigned Bt_, int M, int N, int K_, int G_, int c_, int esz = 2) { A = A_; Bt = Bt_; tileA = tileB = (unsigned)(BM * K_ * esz); nM = M / BM; nN = N / BM; nwg = nM * nN; G = G_; c = c_; }
    __device__ bool next(int i, Unit& u) const {
        const long L = (long)i * G + c; if (L >= nwg) return false;
        int wgid = (int)L; { const int q = nwg / NXCD, r = nwg % NXCD, xcd = wgid % NXCD, off = wgid / NXCD; wgid = (xcd < r ? xcd * (q + 1) : r * (q + 1) + (xcd - r) * q) + off; }
        const int nig = WGM * nN, gid = wgid / nig, fm = gid * WGM, gsz = (nM - fm) < WGM ? (nM - fm) : WGM;
        u.pm = fm + ((wgid % nig) % gsz); u.pn = (wgid % nig) / gsz;
        u.a = A + (unsigned)u.pm * tileA; u.b = Bt + (unsigned)u.pn * tileB; u.rows = nullptr; u.nvalid = BM; u.e = 0; u.pos0 = 0; u.chain = 0; u.rlo = 0; u.rhi = BM; u.zoff = 0u; return true;
    }
};

typedef int i32x8 __attribute__((ext_vector_type(8)));
__device__ __forceinline__ i32x8 cat8(bf16x8 a, bf16x8 b) { typedef int i32x4 __attribute__((ext_vector_type(4))); const i32x4 x = __builtin_bit_cast(i32x4, a), y = __builtin_bit_cast(i32x4, b); return (i32x8){x[0], x[1], x[2], x[3], y[0], y[1], y[2], y[3]}; }
__device__ __forceinline__ unsigned cvt_pk_bf16(float lo, float hi) { unsigned r; asm volatile("v_cvt_pk_bf16_f32 %0, %1, %2" : "=v"(r) : "v"(lo), "v"(hi)); return r; }
__device__ __forceinline__ float bf_lo(unsigned w) { return __uint_as_float(w << 16); }
__device__ __forceinline__ float bf_hi(unsigned w) { return __uint_as_float(w & 0xffff0000u); }

template <class Epi, class Sched, bool ALIGN_EPI, int GATHER, bool MIDK, bool FP8 = false>
__device__ __forceinline__ void gemm_phase(PG8_LAS unsigned char* lds, const __amdgpu_buffer_rsrc_t RS, const int wave, const int K, const Sched& S, const Epi& E) {
    int lane = lane_id(); asm volatile("" : "+v"(lane));
    const int wid = wave, tid = wave * 64 + lane, wr = wid >> 2, wc = wid & 3, fr = lane & 15, fq = lane >> 4;
    int nt = FP8 ? K / (2 * BK) : K / BK; asm volatile("" : "+s"(nt));
    const int PBY = FP8 ? K : 2 * K;
    unsigned voffB[2], vbase[2]; int RA[2];
#pragma unroll
    for (int i = 0; i < 2; ++i) { int R, C; if constexpr (FP8) { const int b = tid * 16 + i * 8192; R = b >> 7; C = 8 * (((b >> 4) & 7) ^ g8(R)); } else stage_rc(tid * 16 + i * 8192, R, C);
        const int Rb = (R & ~31) + perm32(R & 31);
        RA[i] = R; vbase[i] = (unsigned)C * 2u; voffB[i] = (unsigned)(Rb * PBY + C * 2); }
    const unsigned kstep = (unsigned)(BK * 2);
    const unsigned hstepu = (unsigned)(HALF * PBY);
    const unsigned hstep = hstepu;
    const unsigned ldsw = (unsigned)wid * 1024u;
    const int aoff = FP8 ? (wr * 64 + fr) * 128 + (((2 * fq) ^ g8(wr * 64 + fr)) << 4) : lds_byte(wr * 64 + fr, fq * 8), boff = FP8 ? (wc * 32 + fr) * 128 + (((2 * fq) ^ g8(wc * 32 + fr)) << 4) : lds_byte(wc * 32 + fr, fq * 8);
    int boffh = boff + 4 * HTB; asm volatile("" : "+v"(boffh));
    const int aoff2 = aoff ^ 16; int boff2h = (boff ^ 16) + 4 * HTB; asm volatile("" : "+v"(boff2h));
#define PG8_SA(b, h) (((b) * 2 + (h)) * HTB)
#define PG8_SB(b, h) ((4 + (b) * 2 + (h)) * HTB)
#define PG8_STAGE(bufoff, gbase, voff) do { _Pragma("unroll") for (int _i = 0; _i < 2; ++_i) \
        __builtin_amdgcn_raw_ptr_buffer_load_lds(RS, (PG8_LAS void*)(lds + (bufoff) + ldsw + _i * 8192), 16, (int)(voff)[_i], (int)(gbase), 0, 0); } while (0)
#define PG8_LDA(dst, b, h) do { _Pragma("unroll") for (int m = 0; m < 4; ++m) _Pragma("unroll") for (int k = 0; k < 2; ++k) dst[m][k] = *(const PG8_LAS bf16x8*)(lds + PG8_SA(b, h) + (FP8 ? (k ? aoff2 : aoff) : aoff + k * 1024) + m * 2048); } while (0)
#define PG8_LDB(dst, b, h) do { _Pragma("unroll") for (int n = 0; n < 2; ++n) _Pragma("unroll") for (int k = 0; k < 2; ++k) dst[n][k] = *(const PG8_LAS bf16x8*)(lds + (PG8_SB(b, h) - 4 * HTB) + (FP8 ? (k ? boff2h : boffh) : boffh + k * 1024) + n * 2048); } while (0)
#define PG8_MMA(ai, bj, At, Bt) do { __builtin_amdgcn_s_setprio(1); _Pragma("unroll") for (int m = 0; m < 4; ++m) _Pragma("unroll") for (int n = 0; n < 2; ++n) { \
        if constexpr (FP8) acc[ai][bj][m][n] = __builtin_amdgcn_mfma_scale_f32_16x16x128_f8f6f4(cat8(Bt[n][0], Bt[n][1]), cat8(At[m][0], At[m][1]), acc[ai][bj][m][n], 0, 0, 0, 0x7f7f7f7f, 0, 0x7f7f7f7f); \
        else { _Pragma("unroll") for (int k = 0; k < 2; ++k) acc[ai][bj][m][n] = __builtin_amdgcn_mfma_f32_16x16x32_bf16(Bt[n][k], At[m][k], acc[ai][bj][m][n], 0, 0, 0); } } __builtin_amdgcn_s_setprio(0); } while (0)
#define A1S(p) (GATHER ? (p) : (p) + hstepu)
#define A1V(v1, v0) (GATHER ? (v1) : (v0))
#define PG8_WAIT_V(n) asm volatile("s_waitcnt vmcnt(" #n ")" ::: "memory")
#define PG8_WAIT_L(n) asm volatile("s_waitcnt lgkmcnt(" #n ")" ::: "memory")
#define PG8_BAR __builtin_amdgcn_s_barrier()
#define PG8_SCHED __builtin_amdgcn_sched_barrier(0)
#define PG8_AOFF(u, dst) do { _Pragma("unroll") for (int _h = 0; _h < 2; ++_h) _Pragma("unroll") for (int _i = 0; _i < 2; ++_i) { \
        if constexpr (GATHER != 0) { const int _r = _h * HALF + RA[_i]; const bool _in = (_r >= (u).rlo) && (_r < (u).rhi); \
            if constexpr (GATHER == 1) { const int _row = _in ? ((u).rows[_r] >> 1) : 0; dst[_h][_i] = (_in ? (unsigned)_row * (unsigned)PBY : (u).zoff) + vbase[_i]; } \
            else dst[_h][_i] = (_in ? (unsigned)_r * (unsigned)PBY : (u).zoff) + vbase[_i]; } \
        else dst[_h][_i] = (unsigned)RA[_i] * (unsigned)PBY + vbase[_i]; }     } while (0)
    Unit cur, nxt; int ui = 0;
    if (!S.next(0, cur)) return;
    f32x4 acc[2][2][4][2];
#pragma unroll
    for (int a = 0; a < 2; ++a)
#pragma unroll
        for (int b = 0; b < 2; ++b)
#pragma unroll
            for (int m = 0; m < 4; ++m)
#pragma unroll
                for (int n = 0; n < 2; ++n) acc[a][b][m][n] = (f32x4){0.f, 0.f, 0.f, 0.f};
    bf16x8 At[4][2], B0[2][2], B1[2][2];
    unsigned va[2][2], na[2][2];
    PG8_AOFF(cur, va);
    unsigned cA = cur.a, cB = cur.b;
    PG8_STAGE(PG8_SB(0, 0), cB, voffB); PG8_STAGE(PG8_SB(0, 1), cB + hstep, voffB); PG8_STAGE(PG8_SA(0, 0), cA, va[0]); PG8_STAGE(PG8_SA(0, 1), A1S(cA), A1V(va[1], va[0]));
    if (wr == 1) PG8_BAR;
    PG8_WAIT_V(2); PG8_BAR;
    PG8_STAGE(PG8_SB(1, 0), cB + kstep, voffB); PG8_STAGE(PG8_SA(1, 0), cA + kstep, va[0]); PG8_STAGE(PG8_SB(1, 1), cB + hstep + kstep, voffB);
    PG8_WAIT_V(6); PG8_BAR;
    for (;;) {
        const bool has_next = S.next(ui + 1, nxt);
        const unsigned nA = has_next ? nxt.a : cA, nB = has_next ? nxt.b : cB;
        if constexpr (GATHER) { if (has_next) { PG8_AOFF(nxt, na); } else {
#pragma unroll
            for (int h = 0; h < 2; ++h)
#pragma unroll
                for (int i = 0; i < 2; ++i) na[h][i] = va[h][i]; } }
        for (int t = 0; t < nt; t += 2) {
            const bool last = (t == nt - 2);
#if CODE_PF
            if (CODE_PF_EPI && last && ui == 0 && wave == 1) {
                unsigned long long pc_; asm volatile("s_getpc_b64 %0" : "=s"(pc_)); const int l_ = lane_id();
                const unsigned long long a_ = (pc_ & ~255ULL) + (unsigned long long)((blockIdx.x >> 3) & 31u) * 512u + (unsigned)(l_ & 31) * 16u;
                if (l_ < 32) __builtin_amdgcn_global_load_lds((const __attribute__((address_space(1))) void*)a_, (PG8_LAS void*)(lds + CODE_PF_DUMP), 16, 0, 0);
            }
#endif
            if constexpr (MIDK) { if (t == nt / 2) { int t2 = lane_id(); asm volatile("" : "+v"(t2)); E.mid(acc, cur, wr, wc, t2 & 15, (t2 >> 4) & 3); } }
            const unsigned a1 = cA + (unsigned)(t + 1) * kstep;
            const unsigned a2 = last ? nA : cA + (unsigned)(t + 2) * kstep, b2 = last ? nB : cB + (unsigned)(t + 2) * kstep;
            const unsigned a3 = a2 + kstep, b3 = b2 + kstep;
            unsigned x0[2], x1[2];
#pragma unroll
            for (int i = 0; i < 2; ++i) { if constexpr (GATHER) { x0[i] = last ? na[0][i] : va[0][i]; x1[i] = last ? na[1][i] : va[1][i]; } else { x0[i] = va[0][i]; x1[i] = va[1][i]; } }
            PG8_LDB(B0, 0, 0); PG8_LDB(B1, 0, 1); PG8_SCHED; PG8_LDA(At, 0, 0); PG8_STAGE(PG8_SA(1, 1), A1S(a1), A1V(va[1], va[0]));
            PG8_WAIT_V(8); PG8_WAIT_L(0); PG8_BAR; PG8_MMA(0, 0, At, B0); PG8_MMA(0, 1, At, B1); PG8_BAR; PG8_SCHED;
            PG8_LDA(At, 0, 1); PG8_STAGE(PG8_SB(0, 0), b2, voffB); PG8_STAGE(PG8_SB(0, 1), b2 + hstep, voffB); PG8_STAGE(PG8_SA(0, 0), a2, x0);
            PG8_WAIT_V(8); PG8_WAIT_L(0); PG8_BAR; PG8_MMA(1, 0, At, B0); PG8_MMA(1, 1, At, B1); PG8_BAR; PG8_SCHED;
            PG8_LDB(B0, 1, 0); PG8_LDB(B1, 1, 1); PG8_SCHED; PG8_LDA(At, 1, 0); PG8_STAGE(PG8_SA(0, 1), A1S(a2), A1V(x1, x0));
            PG8_WAIT_V(8); PG8_WAIT_L(0); PG8_BAR; PG8_MMA(0, 0, At, B0); PG8_MMA(0, 1, At, B1); PG8_BAR; PG8_SCHED;
            PG8_LDA(At, 1, 1); PG8_STAGE(PG8_SB(1, 0), b3, voffB); PG8_STAGE(PG8_SB(1, 1), b3 + hstep, voffB); PG8_STAGE(PG8_SA(1, 0), a3, x0);
            PG8_WAIT_V(8); PG8_WAIT_L(0); PG8_BAR; PG8_MMA(1, 0, At, B0); PG8_MMA(1, 1, At, B1); PG8_BAR; PG8_SCHED;
        }
        if (!cur.chain) {
            if constexpr (ALIGN_EPI) { if (wr == 0) PG8_BAR; }
            { int t2 = lane_id(); asm volatile("" : "+v"(t2)); E(acc, cur, wr, wc, t2 & 15, (t2 >> 4) & 3); }
        }
        if (!has_next) break;
        if (!cur.chain) {
#pragma unroll
            for (int a = 0; a < 2; ++a)
#pragma unroll
                for (int b = 0; b < 2; ++b)
#pragma unroll
                    for (int m = 0; m < 4; ++m)
#pragma unroll
                        for (int n = 0; n < 2; ++n) acc[a][b][m][n] = (f32x4){0.f, 0.f, 0.f, 0.f};
        }
        const bool was_chain = cur.chain != 0;
        cur = nxt; cA = nA; cB = nB; ++ui;
        if constexpr (GATHER) {
#pragma unroll
            for (int h = 0; h < 2; ++h)
#pragma unroll
                for (int i = 0; i < 2; ++i) va[h][i] = na[h][i]; }
        if constexpr (ALIGN_EPI) { if (!was_chain) { if (wr == 1) PG8_BAR; } }
    }
    PG8_WAIT_V(0);
    if constexpr (!ALIGN_EPI) { if (wr == 0) PG8_BAR; }
    PG8_BAR;
#undef PG8_SA
#undef PG8_SB
#undef PG8_STAGE
#undef PG8_LDA
#undef PG8_LDB
#undef PG8_MMA
#undef PG8_WAIT_V
#undef PG8_WAIT_L
#undef PG8_BAR
#undef PG8_SCHED
#undef PG8_AOFF
#undef A1S
#undef A1V
}
}

namespace attn_body {
using bf16=__hip_bfloat16;
using bf16x8=__attribute__((ext_vector_type(8)))short;
using s16x4=__attribute__((ext_vector_type(4)))short;
using f32x16=__attribute__((ext_vector_type(16)))float;
using f32x4v=__attribute__((ext_vector_type(4)))float;
using u32x4=__attribute__((ext_vector_type(4)))unsigned;
constexpr int SEQ=SEQ_,D=64,DM=NH_*D;
constexpr int OPITCH=1024;
constexpr int NW=8,QBLK=32,QB=QBLK*NW,KVBLK=64,NQB=SEQ/QB;
__device__ __forceinline__ int crow(int r,int hi){return (r&3)+8*(r>>2)+4*hi;}
#define SBAR() __builtin_amdgcn_sched_barrier(0)
__device__ __forceinline__ void cmask(f32x16&p0,f32x16&p1,int jb,int qrel,int hi){
  const float NEG=-INFINITY; int kb=64*jb+4*hi;
  #pragma unroll
  for(int r=0;r<16;++r){int kv=kb+(r&3)+8*(r>>2); if(kv>qrel)p0[r]=NEG; if(kv+32>qrel)p1[r]=NEG;}
}
constexpr int NSLOT=3, SLOTB=8192;
constexpr int LDS_K=0, LDS_V=NSLOT*SLOTB, LDS_WS=2*NSLOT*SLOTB, LDS_OST=LDS_WS+NW*64*4, LDS_CT=LDS_OST+NW*4096, LDS_WT=LDS_CT+SEQ*4, LDS_BYTES=LDS_WT+NW*256;
__device__ __forceinline__ void glds16(const void*gsrc,unsigned lds_dst){unsigned keep;
  asm volatile("s_mov_b32 %0, m0\n\ts_mov_b32 m0, %2\n\ts_nop 0\n\tglobal_load_lds_dwordx4 %1, off\n\ts_mov_b32 m0, %0":"=&s"(keep):"v"(gsrc),"s"(lds_dst):"memory");}
typedef float f32x2_t __attribute__((ext_vector_type(2))); typedef __bf16 bf16x2_t __attribute__((ext_vector_type(2)));
__device__ __forceinline__ unsigned cvtpk_s(float lo,float hi){f32x2_t v={lo,hi};bf16x2_t b=__builtin_convertvector(v,bf16x2_t);return __builtin_bit_cast(unsigned,b);}
#define WAIT_BAR(N) asm volatile("s_waitcnt vmcnt(" #N ") lgkmcnt(0)\n\ts_barrier":::"memory")
typedef __attribute__((address_space(3))) const char* lds_cptr;
typedef short v4i16_t __attribute__((ext_vector_type(4)));
#define LDS3 __attribute__((address_space(3)))
__device__ __forceinline__ void kload8(bf16x8*kf,lds_cptr kp){
  kf[0]=*(const LDS3 bf16x8*)(kp);      kf[1]=*(const LDS3 bf16x8*)(kp+512);
  kf[2]=*(const LDS3 bf16x8*)(kp+2048); kf[3]=*(const LDS3 bf16x8*)(kp+2560);
  kf[4]=*(const LDS3 bf16x8*)(kp+4096); kf[5]=*(const LDS3 bf16x8*)(kp+4608);
  kf[6]=*(const LDS3 bf16x8*)(kp+6144); kf[7]=*(const LDS3 bf16x8*)(kp+6656);
}
__device__ __forceinline__ void kload2(bf16x8*kf,lds_cptr kp,int j){ kf[2*j]=*(const LDS3 bf16x8*)(kp+j*2048); kf[2*j+1]=*(const LDS3 bf16x8*)(kp+j*2048+512); }
__device__ __forceinline__ s16x4 vtr(lds_cptr p){ return __builtin_bit_cast(s16x4,__builtin_amdgcn_ds_read_tr16_b64_v4i16((LDS3 v4i16_t*)p)); }
__device__ __forceinline__ void bias_load(f32x16&p0,f32x16&p1,lds_cptr wt,int hi){
  #pragma unroll
  for(int g=0;g<4;++g){
    const f32x4v a=*(const LDS3 f32x4v*)(wt+(2*g+hi)*16); const f32x4v b=*(const LDS3 f32x4v*)(wt+(8+2*g+hi)*16);
    p0[4*g]=a[0];p0[4*g+1]=a[1];p0[4*g+2]=a[2];p0[4*g+3]=a[3]; p1[4*g]=b[0];p1[4*g+1]=b[1];p1[4*g+2]=b[2];p1[4*g+3]=b[3];}
}
__device__ __forceinline__ void pv(f32x16*o,int vb,bf16x8 pa0,bf16x8 pa1,bf16x8 pa2,bf16x8 pa3){
  #pragma unroll
  for(int d0=0;d0<2;++d0){s16x4 lo[4],hi[4];
    #pragma unroll
    for(int ks=0;ks<4;++ks){
      asm volatile("ds_read_b64_tr_b16 %0,%1 offset:%c2":"=&v"(lo[ks]):"v"(vb),"i"(d0*4096+ks*1024):"memory");
      asm volatile("ds_read_b64_tr_b16 %0,%1 offset:%c2":"=&v"(hi[ks]):"v"(vb),"i"(d0*4096+ks*1024+512):"memory");}
    asm volatile("s_waitcnt lgkmcnt(0)":::"memory");SBAR();
    #define PK(k) (bf16x8){lo[k][0],lo[k][1],lo[k][2],lo[k][3],hi[k][0],hi[k][1],hi[k][2],hi[k][3]}
    o[d0]=__builtin_amdgcn_mfma_f32_32x32x16_bf16(pa0,PK(0),o[d0],0,0,0);
    o[d0]=__builtin_amdgcn_mfma_f32_32x32x16_bf16(pa1,PK(1),o[d0],0,0,0);
    o[d0]=__builtin_amdgcn_mfma_f32_32x32x16_bf16(pa2,PK(2),o[d0],0,0,0);
    o[d0]=__builtin_amdgcn_mfma_f32_32x32x16_bf16(pa3,PK(3),o[d0],0,0,0);
    #undef PK
  }
}
#define ATTN_STORE16(p,v) __builtin_amdgcn_raw_buffer_store_b128((v), wsr, (unsigned)((const char*)(p) - wsbase), 0, 0)
__device__ __forceinline__ void attn_unit(int b,int h,int qb,int t0,float m2,const bf16*Q,const bf16*__restrict__ K,const bf16*__restrict__ V,bf16*O,char*shm,const __amdgpu_buffer_rsrc_t wsr,const char*wsbase,const int wave){
  int lane=lane_id(); asm volatile("":"+v"(lane)); const int r32=lane&31,hi=lane>>5; const int wid=wave;
  const long rowbase=(long)b*SEQ; const int q0=qb*QB;
  const bf16*Qw=Q+(rowbase+q0+wid*QBLK)*DM+h*D;
  const bf16*Kh=K+rowbase*DM+h*D,*Vh=V+rowbase*DM+h*D;
  const unsigned lds0=(unsigned)(uintptr_t)shm;
  float*wsf=(float*)(shm+LDS_WS)+wid*64;
  const bf16*ksrc=Kh+(long)lane*DM+wid*8;
  const bf16*vsrc=Vh+(long)(16*(wid&3)+(lane>>2))*DM+(wid>>2)*32+(lane&3)*8;
  const unsigned kdst=lds0+LDS_K+wid*1024, vdst=lds0+LDS_V+wid*1024;
  #define DMA_K(t,slot) glds16(ksrc+(long)(t)*KVBLK*DM,(unsigned)__builtin_amdgcn_readfirstlane(kdst+(slot)))
  #define DMA_V(t,slot) glds16(vsrc+(long)(t)*KVBLK*DM,(unsigned)__builtin_amdgcn_readfirstlane(vdst+(slot)))
  const int vb0=(int)(lds0+LDS_V)+((lane>>4)&1)*32+(lane&3)*8+(4*hi+((lane&15)>>2))*64;
  bf16x8 kf[8];
  const lds_cptr shm3=(lds_cptr)shm; const lds_cptr kp0=shm3+LDS_K+hi*1024+r32*16; const lds_cptr vp0=shm3+LDS_V+((lane>>4)&1)*32+(lane&3)*8+(4*hi+((lane&15)>>2))*64;
  const lds_cptr ct=shm3+LDS_CT; const lds_cptr wt=shm3+LDS_WT+wid*256;
  LDS3 float* wtw=(LDS3 float*)(shm3+LDS_WT+wid*256)+lane;
  const int NT=(q0+QB)/KVBLK;
  const float kw=-(*(const LDS3 float*)(ct+(q0+wid*QBLK+QBLK-1)*4))-m2;
  #define WTAB(t) do{ const float cv_=*(const LDS3 float*)(ct+((t)*KVBLK+lane)*4); *wtw=cv_+kw; }while(0)
  DMA_K(t0,0);DMA_V(t0,0);DMA_K(t0+1,SLOTB);
  bf16x8 qr[4];
  #pragma unroll
  for(int d0=0;d0<4;++d0)qr[d0]=*reinterpret_cast<const bf16x8*>(&Qw[(long)r32*DM+d0*16+hi*8]);
  float l_reg=0.f;f32x16 o[2];o[0]=f32x16{};o[1]=f32x16{};
  const int qrel=wid*QBLK+r32;
  #define CMASK(P0,P1,t) do{int jb_=(t)-(NT-4); if(jb_>=0)cmask(P0,P1,jb_,qrel,hi);}while(0)
  f32x16 pA0,pA1,pB0,pB1;
  int sl_prev=0,sl_cur=0,sl_next=SLOTB;
  #define ROT() do{sl_prev=sl_cur;sl_cur=sl_next;sl_next=(sl_next==(NSLOT-1)*SLOTB)?0:sl_next+SLOTB;}while(0)
  DMA_K(t0+2,2*SLOTB);
  WTAB(t0);
  WAIT_BAR(3);
  bias_load(pA0,pA1,wt,hi);
  { const char*kb=shm+LDS_K+hi*1024+r32*16;
    #pragma unroll
    for(int d0=0;d0<4;++d0){
      const bf16x8 b0=*reinterpret_cast<const bf16x8*>(kb+d0*2048);
      const bf16x8 b1=*reinterpret_cast<const bf16x8*>(kb+d0*2048+512);
      pA0=__builtin_amdgcn_mfma_f32_32x32x16_bf16(b0,qr[d0],pA0,0,0,0);pA1=__builtin_amdgcn_mfma_f32_32x32x16_bf16(b1,qr[d0],pA1,0,0,0);} }
  CMASK(pA0,pA1,t0);
  _Pragma("unroll") for(int r=0;r<16;++r){pA0[r]=__builtin_amdgcn_exp2f(pA0[r]);pA1[r]=__builtin_amdgcn_exp2f(pA1[r]);}
  WTAB(t0+1);
  WAIT_BAR(0);
  DMA_K(t0+3,0);DMA_V(t0+1,SLOTB);
  ROT();
  kload8(kf,kp0+sl_cur);
  bias_load(pB0,pB1,wt,hi);
  WAIT_BAR(2);
  s16x4 vlo[8],vhi[8]; u32x4 pw0,pw1,pw2,pw3;
  #define PKW(P,B) cvtpk_s(P[B],P[B+1])
  #define PAF(k) __builtin_bit_cast(bf16x8,pw##k)
  #define VFR(i) (bf16x8){vlo[i][0],vlo[i][1],vlo[i][2],vlo[i][3],vhi[i][0],vhi[i][1],vhi[i][2],vhi[i][3]}
  #define PIN(x) asm volatile("":"+v"(x))
  #define GAPA(MF,A0,A1,A2,A3,W0,W1,PW) do{ MF; sacc+=A0; sacc+=A1; sacc+=A2; sacc+=A3; PIN(sacc); W0; W1; PIN(PW); SBAR(); }while(0)
  #define EX(v) __builtin_amdgcn_exp2f(v)
  #define GAPB(MF,X,B) do{ MF; X[B]=EX(X[B]); X[B+1]=EX(X[B+1]); X[B+2]=EX(X[B+2]); X[B+3]=EX(X[B+3]); PIN(X); SBAR(); }while(0)
  #define VRD(i) do{ vlo[i]=vtr(vp_+(((i)>>2)*4096+((i)&3)*1024)); vhi[i]=vtr(vp_+(((i)>>2)*4096+((i)&3)*1024+512)); }while(0)
  #define KRD(G,j) do{ if(G){ kload2(kf,kp0+sl_next,j); SBAR(); } }while(0)
  #define STEP(C0,C1,P0,P1,t,GK,GV,GL) do{ SBAR(); \
    const lds_cptr vp_=vp0+sl_prev; \
    VRD(0); SBAR(); float sacc=(P0[0]+P0[1]); \
    GAPA(C0=__builtin_amdgcn_mfma_f32_32x32x16_bf16(kf[0],qr[0],C0,0,0,0), P0[2],P0[3],P0[4],P0[5],     pw0[0]=PKW(P0,0), pw0[1]=PKW(P0,2), pw0); \
    VRD(4); SBAR(); GAPA(C1=__builtin_amdgcn_mfma_f32_32x32x16_bf16(kf[1],qr[0],C1,0,0,0), P0[6],P0[7],P0[8],P0[9],     pw0[2]=PKW(P0,4), pw0[3]=PKW(P0,6), pw0); \
    VRD(1); SBAR(); GAPA(C0=__builtin_amdgcn_mfma_f32_32x32x16_bf16(kf[2],qr[1],C0,0,0,0),   P0[10],P0[11],P0[12],P0[13], pw1[0]=PKW(P0,8), pw1[1]=PKW(P0,10), pw1); \
    VRD(5); SBAR(); GAPA(C1=__builtin_amdgcn_mfma_f32_32x32x16_bf16(kf[3],qr[1],C1,0,0,0),   P0[14],P0[15],P1[0],P1[1],   pw1[2]=PKW(P0,12),pw1[3]=PKW(P0,14), pw1); \
    VRD(2); SBAR(); GAPA(C0=__builtin_amdgcn_mfma_f32_32x32x16_bf16(kf[4],qr[2],C0,0,0,0),   P1[2],P1[3],P1[4],P1[5],     pw2[0]=PKW(P1,0), pw2[1]=PKW(P1,2), pw2); \
    VRD(6); SBAR(); GAPA(C1=__builtin_amdgcn_mfma_f32_32x32x16_bf16(kf[5],qr[2],C1,0,0,0),   P1[6],P1[7],P1[8],P1[9],     pw2[2]=PKW(P1,4), pw2[3]=PKW(P1,6), pw2); \
    VRD(3); SBAR(); GAPA(C0=__builtin_amdgcn_mfma_f32_32x32x16_bf16(kf[6],qr[3],C0,0,0,0),   P1[10],P1[11],P1[12],P1[13], pw3[0]=PKW(P1,8), pw3[1]=PKW(P1,10), pw3); \
    VRD(7); SBAR(); GAPA(C1=__builtin_amdgcn_mfma_f32_32x32x16_bf16(kf[7],qr[3],C1,0,0,0),   P1[14],P1[15],0.f,0.f,       pw3[2]=PKW(P1,12),pw3[3]=PKW(P1,14), pw3); \
    l_reg+=sacc; \
    if(GK){DMA_K((t)+3,sl_cur);} if(GV){DMA_V((t)+1,sl_next);} \
    CMASK(C0,C1,t); \
    if(GL){ WTAB((t)+1); } \
    SBAR(); \
    GAPB(o[0]=__builtin_amdgcn_mfma_f32_32x32x16_bf16(PAF(0),VFR(0),o[0],0,0,0), C0,0); \
    GAPB(o[1]=__builtin_amdgcn_mfma_f32_32x32x16_bf16(PAF(0),VFR(4),o[1],0,0,0), C0,4); \
    KRD(GL,0); GAPB(o[0]=__builtin_amdgcn_mfma_f32_32x32x16_bf16(PAF(1),VFR(1),o[0],0,0,0), C0,8); \
    KRD(GL,1); GAPB(o[1]=__builtin_amdgcn_mfma_f32_32x32x16_bf16(PAF(1),VFR(5),o[1],0,0,0), C0,12); \
    KRD(GL,2); GAPB(o[0]=__builtin_amdgcn_mfma_f32_32x32x16_bf16(PAF(2),VFR(2),o[0],0,0,0), C1,0); \
    KRD(GL,3); GAPB(o[1]=__builtin_amdgcn_mfma_f32_32x32x16_bf16(PAF(2),VFR(6),o[1],0,0,0), C1,4); \
    GAPB(o[0]=__builtin_amdgcn_mfma_f32_32x32x16_bf16(PAF(3),VFR(3),o[0],0,0,0), C1,8); \
    GAPB(o[1]=__builtin_amdgcn_mfma_f32_32x32x16_bf16(PAF(3),VFR(7),o[1],0,0,0), C1,12); \
    if(GL){ bias_load(P0,P1,wt,hi); } \
    }while(0)
  int t=t0+1;
  #undef CMASK
  #define CMASK(P0,P1,t) do{}while(0)
  for(;t+5<NT;t+=2){
    STEP(pB0,pB1,pA0,pA1,t,true,true,true);     WAIT_BAR(2); ROT();
    STEP(pA0,pA1,pB0,pB1,t+1,true,true,true);   WAIT_BAR(2); ROT();
  }
  #undef CMASK
  #define CMASK(P0,P1,t) do{int jb_=(t)-(NT-4); if(jb_>=0)cmask(P0,P1,jb_,qrel,hi);}while(0)
  #define ENDW(tt) do{ if((tt)+3<NT){WAIT_BAR(2);} else if((tt)+2<NT){WAIT_BAR(1);} else {WAIT_BAR(0);} }while(0)
  for(;t+1<NT;t+=2){
    STEP(pB0,pB1,pA0,pA1,t,(t+3<NT),(t+1<NT),(t+1<NT));       ENDW(t);   ROT();
    STEP(pA0,pA1,pB0,pB1,t+1,(t+4<NT),(t+2<NT),(t+2<NT));     ENDW(t+1); ROT();
  }
  STEP(pB0,pB1,pA0,pA1,NT-1,false,false,false);
  { float sacc=pB0[0]+pB0[1]; _Pragma("unroll") for(int r=2;r<16;++r)sacc+=pB0[r]; _Pragma("unroll") for(int r=0;r<16;++r)sacc+=pB1[r]; l_reg+=sacc;
    pw0=(u32x4){PKW(pB0,0),PKW(pB0,2),PKW(pB0,4),PKW(pB0,6)};pw1=(u32x4){PKW(pB0,8),PKW(pB0,10),PKW(pB0,12),PKW(pB0,14)};pw2=(u32x4){PKW(pB1,0),PKW(pB1,2),PKW(pB1,4),PKW(pB1,6)};pw3=(u32x4){PKW(pB1,8),PKW(pB1,10),PKW(pB1,12),PKW(pB1,14)};
    SBAR(); pv(o,vb0+sl_cur,PAF(0),PAF(1),PAF(2),PAF(3)); }
  #undef PKW
  #undef PAF
  #undef VFR
  #undef PIN
  #undef GAPA
  #undef GAPB
  #undef EX
  #undef VRD
  #undef KRD
  #undef STEP
  #undef ENDW
  {auto rr=__builtin_amdgcn_permlane32_swap(__float_as_uint(l_reg),__float_as_uint(l_reg),false,false);l_reg=__uint_as_float(rr[0])+__uint_as_float(rr[1]);}
  if(hi==0)wsf[32+r32]=l_reg;asm volatile("s_waitcnt lgkmcnt(0)":::"memory");
  float rli[16];
  #pragma unroll
  for(int r=0;r<16;++r)rli[r]=__builtin_amdgcn_rcpf(wsf[32+crow(r,hi)]);
  bf16*Ow=O+(rowbase+q0+wid*QBLK)*OPITCH+h*D;
  { bf16*stg=(bf16*)(shm+LDS_OST)+wid*2048;
    #pragma unroll
    for(int r=0;r<16;++r){const int orow=crow(r,hi);
      #pragma unroll
      for(int d0=0;d0<2;++d0)stg[orow*64+d0*32+r32]=__float2bfloat16(o[d0][r]*rli[r]);}
    asm volatile("s_waitcnt lgkmcnt(0)":::"memory");
    #pragma unroll
    for(int i=0;i<4;++i){const int row=i*8+(lane>>3),ch=lane&7; const u32x4 v=*(const u32x4*)(stg+row*64+ch*8); ATTN_STORE16(Ow+(long)row*OPITCH+ch*8,v);} }
  asm volatile("s_waitcnt lgkmcnt(0)\n\ts_barrier":::"memory");
  #undef DMA_K
  #undef DMA_V
  #undef CMASK
  #undef ROT
  #undef WTAB
}
constexpr int ATTN_LDS_BYTES=LDS_BYTES;
#undef SBAR
#undef WAIT_BAR
}

constexpr size_t MiB = 1u << 20;
constexpr size_t WS_CTL = 0, CTL_ZERO_BYTES = 256 * 1024;
constexpr size_t WS_WIN = 2 * MiB, WS_WAB = 12 * MiB, WS_WO = 14 * MiB, WS_WGU = 16 * MiB, WS_WD = 32 * MiB, WS_WPG = 40 * MiB, WS_WPLE = 42 * MiB, WS_WR = 43 * MiB;
constexpr size_t WS_RSTD1 = 44 * MiB, WS_LF = 44 * MiB + 256 * 1024, WS_C = 45 * MiB, WS_SSQ2 = 46 * MiB, WS_RSTD2 = 47 * MiB, WS_RSTD3 = 47 * MiB + 256 * 1024;
constexpr size_t WS_LIST = 48 * MiB, WS_GATE = 49 * MiB;
constexpr size_t WS_XB = 50 * MiB;
constexpr size_t WS_ACAT = 194 * MiB, WS_HIDP = 50 * MiB;
constexpr size_t HPLANE = (size_t)96 * 256 * 256;
constexpr size_t WS_Q = 82 * MiB, WS_K = 98 * MiB, WS_V = 114 * MiB;
constexpr size_t WS_MG = 82 * MiB, WS_X2B = 82 * MiB;
constexpr size_t WS_X1B = 114 * MiB;
constexpr size_t WS_CCU = 130 * MiB, WS_CB = 146 * MiB;
constexpr size_t WS_U = 146 * MiB;
constexpr size_t WS_R = 162 * MiB, WS_SGB = 178 * MiB;
constexpr size_t WS_PB = 230 * MiB;
constexpr size_t WS_INFO = 238 * MiB;
constexpr size_t WS_CLIST = 239 * MiB;
constexpr size_t WS_SSQ3 = 241 * MiB;
constexpr size_t WS_X2B8 = 194 * MiB, WS_X1B8 = 210 * MiB;
constexpr size_t WS_WIN8 = 226 * MiB;
constexpr size_t WS_XB8 = 238 * MiB;
constexpr size_t WS_ZERO = 254 * MiB;
constexpr size_t WS_END = 254 * MiB + 4096;
static_assert(2 * HPLANE * 2 <= 32 * MiB, "hidden planes fit their region");
constexpr int CW_BAR = 4096;
constexpr int CW_QHEAD = 12288;
constexpr int CW_CNT = 16384;
constexpr int CW_G3 = 20480, CW_G4 = 24576;
static_assert((CW_CNT + 64 * 40) <= CW_G3 && (CW_G4 + 64 * 64) * 4 <= (int)CTL_ZERO_BYTES, "CTL words inside the memset region");
constexpr int RING_OFF = 0, RING_BYTES = 131072;
constexpr int LDSCTL_OFF = RING_BYTES, MISC_OFF = LDSCTL_OFF + 320;
constexpr int MOE_TAB_OFF = LDSCTL_OFF + 1024;
constexpr int LDS_BYTES = 147456;
static_assert(MISC_OFF + 128 <= MOE_TAB_OFF && MOE_TAB_OFF + 1024 + 1024 <= LDS_BYTES, "LDS map");
constexpr int NWAVES = 8;

#define GAS __attribute__((address_space(1)))
#define LAS __attribute__((address_space(3)))
typedef unsigned short bf16;
typedef unsigned v4u __attribute__((ext_vector_type(4)));
typedef float f32x4 __attribute__((ext_vector_type(4)));
typedef short bf16x8 __attribute__((ext_vector_type(8)));
typedef GAS unsigned gu32;
typedef GAS unsigned long long gu64;
#define RLX_AGENT __ATOMIC_RELAXED, __HIP_MEMORY_SCOPE_AGENT
#define LDS_WAIT() asm volatile("s_waitcnt lgkmcnt(0)" ::: "memory")
#define VM_WAIT() asm volatile("s_waitcnt vmcnt(0)" ::: "memory")
__device__ __forceinline__ unsigned long long rt() { return __builtin_amdgcn_s_memrealtime(); }
__device__ __forceinline__ unsigned f2bf(float f) { unsigned u = __builtin_bit_cast(unsigned, f); return (u + 0x7fffu + ((u >> 16) & 1u)) >> 16; }
__device__ __forceinline__ unsigned pk2(float lo, float hi) { return f2bf(lo) | (f2bf(hi) << 16); }

#define XB_TMO      128
#define XB_XCNT(j)  (256  + 64 * (j))
#define XB_XSUB(j)  (1280 + 64 * (j))
#define XB_XGEN(j)  (2304 + 64 * (j))
#define XB_TOP      3328
#define XB_TOPGEN   3392
#define XCD_BAR_WORDS 3456
#define XB_SPIN_CAP (1u << 18)

__device__ __forceinline__ unsigned xb_ld(unsigned* p)              { return __hip_atomic_load(p, __ATOMIC_RELAXED, __HIP_MEMORY_SCOPE_AGENT); }
__device__ __forceinline__ unsigned xb_add(unsigned* p, unsigned v) { return __hip_atomic_fetch_add(p, v, __ATOMIC_RELAXED, __HIP_MEMORY_SCOPE_AGENT); }
__device__ __forceinline__ unsigned xb_xcc_id() { return (unsigned)__builtin_amdgcn_s_getreg((3 << 11) | 20) & 0xFu; }
#define XB_SPIN(cond, bar) do { unsigned _sp = 0; while (cond) { __builtin_amdgcn_s_sleep(1); \
    if ((++_sp & 255u) == 0u) { if (xb_ld(&(bar)[XB_TMO])) break; if (_sp > XB_SPIN_CAP) { atomicAdd(&(bar)[XB_TMO], 1u); break; } } } } while (0)

struct XcdBarrier {
    unsigned* bar; unsigned x;
    volatile LAS unsigned* st;
};

__device__ __forceinline__ XcdBarrier xcd_barrier_post(unsigned* bar, volatile LAS unsigned* st, const int tid_) {
    XcdBarrier b; b.bar = bar; b.x = xb_xcc_id(); b.st = st;
    if (tid_ == 0) (void)xb_add(&bar[XB_XCNT(b.x)], 1u);
#if CODE_PF
    if (tid_ == 0) { unsigned long long pc_; asm volatile("s_getpc_b64 %0" : "=s"(pc_)); pc_ &= ~4095ULL; st[2] = (unsigned)pc_; st[3] = (unsigned)(pc_ >> 32); }
#endif
    return b;
}
__device__ __forceinline__ void xcd_barrier_complete(unsigned* bar, unsigned x, unsigned& nloc, unsigned& nx) {
    const unsigned G = gridDim.x * gridDim.y * gridDim.z;
    unsigned sum, cnt, mine, sp = 0u;
    for (;;) {
        sum = 0u; cnt = 0u; mine = 0u;
#pragma unroll
        for (unsigned j = 0; j < 16; ++j) { const unsigned c = xb_ld(&bar[XB_XCNT(j)]); sum += c; cnt += (c > 0u) ? 1u : 0u; mine = (j == x) ? c : mine; }
        if (sum == G) break;
        __builtin_amdgcn_s_sleep(1);
        if ((++sp & 255u) == 0u) { if (xb_ld(&bar[XB_TMO])) break; if (sp > XB_SPIN_CAP) { atomicAdd(&bar[XB_TMO], 1u); break; } }
    }
    nloc = mine > 0u ? mine : 1u; nx = cnt > 0u ? cnt : 1u;
}

__device__ __forceinline__ void xcd_barrier(const XcdBarrier& b, const int tid_) {
    asm volatile("s_waitcnt vmcnt(0)" ::: "memory");
    __syncthreads();
#if CODE_PF
    if (tid_ >= 64 && tid_ < 64 + 64 * CODE_PF) {
        unsigned long long pc_; asm volatile("s_getpc_b64 %0" : "=s"(pc_));
        const unsigned long long lo_ = (pc_ & ~255ULL) + (unsigned long long)((blockIdx.x >> 3) & 31u) * (1024u * CODE_PF) + (unsigned)(tid_ - 64) * 16u;
        const unsigned long long end_ = ((unsigned long long)b.st[3] << 32 | b.st[2]) + CODE_PF_SAFE;
        if (lo_ + 16u <= end_) { v4u t_; asm volatile("global_load_dwordx4 %0, %1, off\n\ts_waitcnt vmcnt(0)" : "=&v"(t_) : "v"(lo_) : "memory"); }
    }
#endif
    if (tid_ == 0) {
        unsigned* bar = b.bar;
        __builtin_amdgcn_s_waitcnt(0);
        unsigned nloc = b.st[0], nx = b.st[1];
        if (nloc == 0u) { xcd_barrier_complete(bar, b.x, nloc, nx); b.st[0] = nloc; b.st[1] = nx; }
        const unsigned old = xb_add(&bar[XB_XSUB(b.x)], 1u);
        const unsigned gen = old / nloc;
        if (old + 1u == (gen + 1u) * nloc) {
            __builtin_amdgcn_fence(__ATOMIC_RELEASE, "agent");
            asm volatile("s_waitcnt vmcnt(0)" ::: "memory");
            const unsigned og = xb_add(&bar[XB_TOP], 1u);
            const unsigned tg = og / nx;
            if (og + 1u == (tg + 1u) * nx) xb_add(&bar[XB_TOPGEN], 1u);
            else XB_SPIN(xb_ld(&bar[XB_TOPGEN]) == tg, bar);
            __builtin_amdgcn_fence(__ATOMIC_ACQUIRE, "agent");
            xb_add(&bar[XB_XGEN(b.x)], 1u);
            asm volatile("s_waitcnt vmcnt(0)" ::: "memory");
        } else {
#if EARLY_WB
            asm volatile("buffer_wbl2 sc1" ::: "memory");
#endif
            XB_SPIN(xb_ld(&bar[XB_XGEN(b.x)]) == gen, bar);
            __builtin_amdgcn_fence(__ATOMIC_ACQUIRE, "agent");
            asm volatile("s_waitcnt vmcnt(0)" ::: "memory");
        }
    }
    __syncthreads();
}


struct Args { const float* in[22]; float* out; unsigned char* ws; };
struct Frame {
    LAS unsigned char* lds; volatile LAS unsigned* MISC; gu32* ctl;
    int tid, lane, wave, vcu, G;
};
__device__ __forceinline__ float wave_sum(float v) {
#pragma unroll
    for (int o = 1; o < 64; o <<= 1) v += __shfl_xor(v, o);
    return v;
}
__device__ __forceinline__ void conv_item(const float* W, int ld, int scol, const float* g, bf16* WT, int Kd, int drow, int kd0, LAS float* scr, int lane) {
#pragma unroll 8
    for (int i = 0; i < 32; ++i) { const int kk = 2 * i + (lane >> 5); const float gv = g ? g[kk] : 1.f; scr[kk * 33 + (lane & 31)] = W[(size_t)kk * ld + scol + (lane & 31)] * gv; }
    LDS_WAIT(); asm volatile("" ::: "memory");
    const int c = lane & 7;
#pragma unroll
    for (int j = 0; j < 4; ++j) { const int n = (lane >> 3) + 8 * j; const LAS float* s = scr + (8 * c) * 33 + n;
        v4u o; o.x = pk2(s[0 * 33], s[1 * 33]); o.y = pk2(s[2 * 33], s[3 * 33]); o.z = pk2(s[4 * 33], s[5 * 33]); o.w = pk2(s[6 * 33], s[7 * 33]);
        *(GAS v4u*)(WT + (size_t)(drow + n) * Kd + kd0 + 8 * c) = o; }
    LDS_WAIT(); asm volatile("" ::: "memory");
}
__device__ __forceinline__ int win_scol(int ng) {
    const int pn = ng >> 3, gidx = ng & 7, bj = gidx >> 2, wc = gidx & 3;
    if (pn < 2) return OFF_Q + (4 * pn + wc) * 64 + 32 * bj;
    if (pn < 4) return OFF_K + (4 * (pn - 2) + wc) * 64 + 32 * bj;
    if (pn < 6) return OFF_V + (4 * (pn - 4) + wc) * 64 + 32 * bj;
    if (pn < 10) return (bj ? OFF_CU : OFF_CC) + (pn - 6) * 128 + 32 * wc;
    if (pn < 12) return OFF_CB + (pn - 10) * 256 + 32 * gidx;
    return (bj ? OFF_GB : OFF_GA) + (pn - 12) * 128 + 32 * wc;
}

using pg8::u32x4; using pg8::Unit; using pg8::cvt_pk_bf16; using pg8::bf_lo; using pg8::bf_hi;
typedef __amdgpu_buffer_rsrc_t wsrc_t;
#ifndef WT_AUX
#define WT_AUX 0
#endif
#define WTS(R, byteoff, val) __builtin_amdgcn_raw_buffer_store_b128((val), (R), (unsigned)(byteoff), 0, WT_AUX)
#define EPI_ARGS const f32x4 (&acc)[2][2][4][2], const Unit& u, int wr, int wc, int fr, int fq
#define EPI_OPAQUE() asm volatile("" : "+v"(fr), "+v"(fq))
__device__ __forceinline__ u32x4 pack8(const f32x4 a, const f32x4 b) { u32x4 w; w.x = cvt_pk_bf16(a[0], a[1]); w.y = cvt_pk_bf16(a[2], a[3]); w.z = cvt_pk_bf16(b[0], b[1]); w.w = cvt_pk_bf16(b[2], b[3]); return w; }
__device__ __forceinline__ void unpack8(const u32x4 w, f32x4& a, f32x4& b) { a = (f32x4){bf_lo(w.x), bf_hi(w.x), bf_lo(w.y), bf_hi(w.y)}; b = (f32x4){bf_lo(w.z), bf_hi(w.z), bf_lo(w.w), bf_hi(w.w)}; }
__device__ __forceinline__ float xor16_add(float v) { return v + __int_as_float(__builtin_amdgcn_ds_swizzle(__float_as_int(v), 0x401F)); }
__device__ __forceinline__ float xor32_add(float v) { auto r = __builtin_amdgcn_permlane32_swap(__float_as_uint(v), __float_as_uint(v), false, false); return __uint_as_float(r[0]) + __uint_as_float(r[1]); }
__device__ __forceinline__ pg8::u32x2 pack8_fp8(const f32x4 a, const f32x4 b) { int w0 = __builtin_amdgcn_cvt_pk_fp8_f32(a[0], a[1], 0, false); w0 = __builtin_amdgcn_cvt_pk_fp8_f32(a[2], a[3], w0, true);
    int w1 = __builtin_amdgcn_cvt_pk_fp8_f32(b[0], b[1], 0, false); w1 = __builtin_amdgcn_cvt_pk_fp8_f32(b[2], b[3], w1, true); return (pg8::u32x2){(unsigned)w0, (unsigned)w1}; }
__device__ __forceinline__ unsigned pack4_u8(const f32x4 v) { int w = __builtin_amdgcn_cvt_pk_u8_f32(v[0], 0, 0); w = __builtin_amdgcn_cvt_pk_u8_f32(v[1], 1, w); w = __builtin_amdgcn_cvt_pk_u8_f32(v[2], 2, w); return (unsigned)__builtin_amdgcn_cvt_pk_u8_f32(v[3], 3, w); }
__device__ __forceinline__ f32x4 unpack4_u8(unsigned w) { return (f32x4){(float)(w & 0xffu), (float)((w >> 8) & 0xffu), (float)((w >> 16) & 0xffu), (float)(w >> 24)}; }
__device__ __forceinline__ float sigm_c(float v) { v = fminf(fmaxf(v, -60.f), 60.f); return __builtin_amdgcn_rcpf(1.f + __builtin_amdgcn_exp2f(-v * LOG2E)); }

#define GROUP_ROW(g) (((g) >> 2) * 128 + wr * 64 + ((g) & 3) * 16 + fr)
struct EpiP1 {
    const float* rstd1; const float* gq; const float* gk; wsrc_t W; unsigned Q, Kb, V, CCU, CB; unsigned char* R8; unsigned char* SGB8;
    float wscale;
    __device__ __forceinline__ void operator()(EPI_ARGS) const { EPI_OPAQUE();
        const int pn = u.pn, row0 = u.pm * 256;
        float rsv[8];
#pragma unroll
        for (int g = 0; g < 8; ++g) rsv[g] = rstd1[row0 + GROUP_ROW(g)] * wscale;
        if (pn < 4) {
            const bool isk = pn >= 2; const float* gg = isk ? gk : gq; const int head = 4 * (pn & 1) + wc; const float sc = isk ? 1.f : QC2;
            const unsigned base = (isk ? Kb : Q) + (unsigned)(head * 64 + 8 * fq) * 2u;
#pragma unroll
            for (int g = 0; g < 8; ++g) { const int ai = g >> 2, m = g & 3; const int row = row0 + GROUP_ROW(g); const float rs = rsv[g];
                f32x4 g4[2][2];
#pragma unroll
                for (int bj = 0; bj < 2; ++bj)
#pragma unroll
                    for (int n = 0; n < 2; ++n) g4[bj][n] = *(const f32x4*)(gg + 32 * bj + 8 * fq + 4 * n) * sc;
                f32x4 v[2][2]; float ss = 0.f;
#pragma unroll
                for (int bj = 0; bj < 2; ++bj)
#pragma unroll
                    for (int n = 0; n < 2; ++n) { v[bj][n] = acc[ai][bj][m][n] * rs; ss += (v[bj][n][0] * v[bj][n][0] + v[bj][n][1] * v[bj][n][1]) + (v[bj][n][2] * v[bj][n][2] + v[bj][n][3] * v[bj][n][3]); }
                ss = xor16_add(ss); ss = xor32_add(ss);
                const float r = __builtin_amdgcn_rsqf(ss * (1.f / 64.f) + EPS_);
#pragma unroll
                for (int bj = 0; bj < 2; ++bj) WTS(W, base + (unsigned)(row * 512 + 32 * bj) * 2u, pack8(v[bj][0] * r * g4[bj][0], v[bj][1] * r * g4[bj][1])); }
        } else if (pn < 6) {
            const unsigned base = V + (unsigned)((4 * (pn - 4) + wc) * 64 + 8 * fq) * 2u;
#pragma unroll
            for (int g = 0; g < 8; ++g) { const int ai = g >> 2, m = g & 3; const int row = row0 + GROUP_ROW(g); const float rs = rsv[g];
#pragma unroll
                for (int bj = 0; bj < 2; ++bj) WTS(W, base + (unsigned)(row * 512 + 32 * bj) * 2u, pack8(acc[ai][bj][m][0] * rs, acc[ai][bj][m][1] * rs)); }
        } else if (pn < 10) {
            const unsigned base = CCU + (unsigned)((pn - 6) * 128 + 32 * wc + 8 * fq) * 2u;
#pragma unroll
            for (int g = 0; g < 8; ++g) { const int ai = g >> 2, m = g & 3; const int row = row0 + GROUP_ROW(g); const float r2 = rsv[g] * rsv[g];
                WTS(W, base + (unsigned)(row * 512) * 2u, pack8(acc[ai][0][m][0] * acc[ai][1][m][0] * r2, acc[ai][0][m][1] * acc[ai][1][m][1] * r2)); }
        } else if (pn < 12) {
            const unsigned base = CB + (unsigned)((pn - 10) * 256 + 32 * wc + 8 * fq) * 2u;
#pragma unroll
            for (int g = 0; g < 8; ++g) { const int ai = g >> 2, m = g & 3; const int row = row0 + GROUP_ROW(g); const float rs = rsv[g];
#pragma unroll
                for (int bj = 0; bj < 2; ++bj) WTS(W, base + (unsigned)(row * 512 + 128 * bj) * 2u, pack8(acc[ai][bj][m][0] * rs, acc[ai][bj][m][1] * rs)); }
        } else {
            const int ch = (pn - 12) * 128 + 32 * wc + 8 * fq;
#pragma unroll
            for (int g = 0; g < 8; ++g) { const int ai = g >> 2, m = g & 3; const int row = row0 + GROUP_ROW(g); const float rs = rsv[g];
                f32x4 sa[2], sg[2];
#pragma unroll
                for (int n = 0; n < 2; ++n)
#pragma unroll
                    for (int j = 0; j < 4; ++j) { const float ga = fminf(fmaxf(acc[ai][0][m][n][j] * rs, -60.f), 60.f), gb = fminf(fmaxf(acc[ai][1][m][n][j] * rs, -60.f), 60.f);
                        sa[n][j] = 255.f * __builtin_amdgcn_rcpf(1.f + __builtin_amdgcn_exp2f(-ga * LOG2E)); sg[n][j] = fmaxf(255.f * __builtin_amdgcn_rcpf(1.f + __builtin_amdgcn_exp2f(-gb * LOG2E)), 1.f); }
                *(pg8::u32x2*)(R8 + (size_t)row * 1024 + ch) = (pg8::u32x2){pack4_u8(sa[0]), pack4_u8(sa[1])}; *(pg8::u32x2*)(SGB8 + (size_t)row * 1024 + ch) = (pg8::u32x2){pack4_u8(sg[0]), pack4_u8(sg[1])}; }
        }
    }
};
struct EpiMerged {
    const unsigned char* R8; const unsigned char* SGB8; wsrc_t W; unsigned MG;
    __device__ __forceinline__ void mid(f32x4 (&acc)[2][2][4][2], const Unit& u, int wr, int wc, int fr, int fq) const { EPI_OPAQUE();
        const size_t base = (size_t)u.pm * 256 * 1024 + u.pn * 256 + wc * 32 + 8 * fq;
#pragma unroll
        for (int h = 0; h < 2; ++h) { pg8::u32x2 wa[4][2], wb[4][2];
#pragma unroll
            for (int k = 0; k < 4; ++k)
#pragma unroll
                for (int bj = 0; bj < 2; ++bj) { const size_t off = base + (size_t)GROUP_ROW(4 * h + k) * 1024 + 128 * bj; wa[k][bj] = *(const pg8::u32x2*)(R8 + off); wb[k][bj] = *(const pg8::u32x2*)(SGB8 + off); }
#pragma unroll
            for (int k = 0; k < 4; ++k)
#pragma unroll
                for (int bj = 0; bj < 2; ++bj)
#pragma unroll
                    for (int n = 0; n < 2; ++n) { const f32x4 a = unpack4_u8(n ? wa[k][bj].y : wa[k][bj].x), b = unpack4_u8(n ? wb[k][bj].y : wb[k][bj].x);
#pragma unroll
                        for (int j = 0; j < 4; ++j) acc[h][bj][k][n][j] *= a[j] * __builtin_amdgcn_rcpf(b[j]); }
            asm volatile("" ::: "memory"); }
    }
    __device__ __forceinline__ void operator()(EPI_ARGS) const { EPI_OPAQUE();
        const size_t base = (size_t)u.pm * 256 * 1024 + u.pn * 256 + wc * 32 + 8 * fq;
        pg8::u32x2 wb[8][2];
#pragma unroll
        for (int g = 0; g < 8; ++g)
#pragma unroll
            for (int bj = 0; bj < 2; ++bj) wb[g][bj] = *(const pg8::u32x2*)(SGB8 + base + (size_t)GROUP_ROW(g) * 1024 + 128 * bj);
#pragma unroll
        for (int g = 0; g < 8; ++g)
#pragma unroll
            for (int bj = 0; bj < 2; ++bj) { const f32x4 a = unpack4_u8(wb[g][bj].x) * (1.f / 255.f), b = unpack4_u8(wb[g][bj].y) * (1.f / 255.f);
                WTS(W, MG + (unsigned)(base + (size_t)GROUP_ROW(g) * 1024 + 128 * bj) * 2u, pack8(acc[g >> 2][bj][g & 3][0] * a, acc[g >> 2][bj][g & 3][1] * b)); }
    }
};
struct EpiX1 {
    const bf16* x; wsrc_t W; unsigned X1B; float* SSQ; unsigned char* X1B8;
    struct In { u32x4 v[2][2]; };
    __device__ __forceinline__ void load(In& I, size_t base, int p, int wr, int fr) const {
#pragma unroll
        for (int q = 0; q < 2; ++q)
#pragma unroll
            for (int bj = 0; bj < 2; ++bj) I.v[q][bj] = *(const u32x4*)(x + base + (size_t)GROUP_ROW(2 * p + q) * 1024 + 128 * bj);
    }
    __device__ __forceinline__ void apply(const In& I, const f32x4 (&acc)[2][2][4][2], const Unit& u, size_t base, int p, int wr, int wc, int fr, int fq) const {
#pragma unroll
        for (int q = 0; q < 2; ++q) { const int g = 2 * p + q, ai = g >> 2, m = g & 3; const int trow = GROUP_ROW(g); float ss = 0.f;
#pragma unroll
            for (int bj = 0; bj < 2; ++bj) { f32x4 a, b; unpack8(I.v[q][bj], a, b); a += acc[ai][bj][m][0]; b += acc[ai][bj][m][1];
                const u32x4 w = pack8(a, b); WTS(W, X1B + (unsigned)(base + (size_t)trow * 1024 + 128 * bj) * 2u, w); f32x4 ra, rb; unpack8(w, ra, rb);
                *(pg8::u32x2*)(X1B8 + base + (size_t)trow * 1024 + 128 * bj) = pack8_fp8(ra, rb);
                ss += (ra[0] * ra[0] + ra[1] * ra[1]) + (ra[2] * ra[2] + ra[3] * ra[3]) + (rb[0] * rb[0] + rb[1] * rb[1]) + (rb[2] * rb[2] + rb[3] * rb[3]); }
            ss = xor16_add(ss); ss = xor32_add(ss);
            if (fq == 0) SSQ[(size_t)(u.pm * 256 + trow) * 16 + u.pn * 4 + wc] = ss; }
    }
    __device__ __forceinline__ void operator()(EPI_ARGS) const { EPI_OPAQUE();
        const size_t base = (size_t)u.pm * 256 * 1024 + u.pn * 256 + wc * 32 + 8 * fq;
        In A, B;
        load(A, base, 0, wr, fr); load(B, base, 1, wr, fr);
        apply(A, acc, u, base, 0, wr, wc, fr, fq); load(A, base, 2, wr, fr);
        apply(B, acc, u, base, 1, wr, wc, fr, fq); load(B, base, 3, wr, fr);
        apply(A, acc, u, base, 2, wr, wc, fr, fq);
        apply(B, acc, u, base, 3, wr, wc, fr, fq);
    }
};
struct EpiPlain { wsrc_t W; unsigned O; int ldc;
    __device__ __forceinline__ void operator()(EPI_ARGS) const { EPI_OPAQUE();
        const int row0 = u.pm * 256 + wr * 64 + fr, col0 = u.pn * 256 + wc * 32 + 8 * fq;
#pragma unroll
        for (int ai = 0; ai < 2; ++ai)
#pragma unroll
            for (int m = 0; m < 4; ++m) { const size_t off = (size_t)(row0 + ai * 128 + m * 16) * ldc + col0;
#pragma unroll
                for (int bj = 0; bj < 2; ++bj) WTS(W, O + (unsigned)(off + 128 * bj) * 2u, pack8(acc[ai][bj][m][0], acc[ai][bj][m][1])); }
    }
};
struct EpiHid { const float* RSTD2; const int* LIST; const float* GATE; const int* INFO; unsigned char* HIDP8; const LAS int* ebase; const LAS int* cbase;
    __device__ __forceinline__ void operator()(EPI_ARGS) const { EPI_OPAQUE();
#pragma unroll
        for (int hh = 0; hh < 2; ++hh) {
        int ent[4], inf[4]; float gw[4], rs[4];
#pragma unroll
        for (int k = 0; k < 4; ++k) { const int gpos = u.pm * 256 + GROUP_ROW(4 * hh + k); int e = 0;
#pragma unroll
            for (int j = 1; j < 16; ++j) e += (ebase[j] <= gpos) ? 1 : 0;
            const size_t li = (size_t)e * ECAP + (gpos - ebase[e]); ent[k] = LIST[li]; inf[k] = INFO[li]; gw[k] = GATE[li]; }
#pragma unroll
        for (int k = 0; k < 4; ++k) rs[k] = RSTD2[ent[k] >> 1] * (1.f / 32.f);
#pragma unroll
        for (int k = 0; k < 4; ++k) { const int ai = hh, m = k;
            f32x4 h[2];
#pragma unroll
            for (int n = 0; n < 2; ++n)
#pragma unroll
                for (int j = 0; j < 4; ++j) { const float a = acc[ai][0][m][n][j] * rs[k], uu = acc[ai][1][m][n][j] * rs[k]; const float ac = fminf(fmaxf(a, -60.f), 60.f);
                    h[n][j] = a * __builtin_amdgcn_rcpf(1.f + __builtin_amdgcn_exp2f(-ac * LOG2E)) * uu * (gw[k] * 16.f); }
            const int cls = inf[k] >> 20, cpos = (inf[k] >> 1) & 0x7ffff; const size_t drow = (size_t)cbase[cls] + cpos;
            *(pg8::u32x2*)(HIDP8 + (size_t)(inf[k] & 1) * HPLANE + drow * 256 + u.pn * 128 + 32 * wc + 8 * fq) = pack8_fp8(h[0], h[1]); }
        asm volatile("" ::: "memory"); }
    }
};
struct EpiX2 { const bf16* X1B; wsrc_t W; unsigned X2B; float* SSQ; unsigned char* X2B8; const int* CLIST; const LAS int* cbase;
    struct In { u32x4 w[2][2]; };
    __device__ __forceinline__ void load(In& I, const int (&tok)[8], size_t cb, int p) const {
#pragma unroll
        for (int q = 0; q < 2; ++q)
#pragma unroll
            for (int bj = 0; bj < 2; ++bj) I.w[q][bj] = *(const u32x4*)(X1B + (size_t)tok[2 * p + q] * 1024 + cb + 128 * bj);
    }
    __device__ __forceinline__ void apply(const In& I, const f32x4 (&acc)[2][2][4][2], const Unit& u, const int (&tok)[8], size_t cb, int p, int wc, int fq) const {
#pragma unroll
        for (int q = 0; q < 2; ++q) { const int g = 2 * p + q, ai = g >> 2, m = g & 3; float ss = 0.f;
#pragma unroll
            for (int bj = 0; bj < 2; ++bj) { f32x4 a, b; unpack8(I.w[q][bj], a, b); a += acc[ai][bj][m][0] * (1.f / 256.f); b += acc[ai][bj][m][1] * (1.f / 256.f);
                const u32x4 w = pack8(a, b); f32x4 ra, rb; unpack8(w, ra, rb);
                WTS(W, X2B + (unsigned)((size_t)tok[g] * 1024 + cb + 128 * bj) * 2u, w); *(pg8::u32x2*)(X2B8 + (size_t)tok[g] * 1024 + cb + 128 * bj) = pack8_fp8(ra, rb);
                ss += (ra[0] * ra[0] + ra[1] * ra[1]) + (ra[2] * ra[2] + ra[3] * ra[3]) + (rb[0] * rb[0] + rb[1] * rb[1]) + (rb[2] * rb[2] + rb[3] * rb[3]); }
            ss = xor16_add(ss); ss = xor32_add(ss);
            if (fq == 0) SSQ[(size_t)tok[g] * 16 + u.pn * 4 + wc] = ss; }
    }
    __device__ __forceinline__ void operator()(EPI_ARGS) const { EPI_OPAQUE();
        int tok[8];
#pragma unroll
        for (int g = 0; g < 8; ++g) { const int gpos = u.pm * 256 + GROUP_ROW(g); int c = 0;
#pragma unroll
            for (int j = 1; j < 24; ++j) c += (cbase[j] <= gpos) ? 1 : 0;
            tok[g] = CLIST[(size_t)c * ECAP + (gpos - cbase[c])]; }
        const size_t cb = (size_t)u.pn * 256 + 32 * wc + 8 * fq;
        In A, B;
        load(A, tok, cb, 0); load(B, tok, cb, 1);
        apply(A, acc, u, tok, cb, 0, wc, fq); load(A, tok, cb, 2);
        apply(B, acc, u, tok, cb, 1, wc, fq); load(B, tok, cb, 3);
        apply(A, acc, u, tok, cb, 2, wc, fq);
        apply(B, acc, u, tok, cb, 3, wc, fq);
    }
};
struct EpiFinal { const LAS float* rsl; const bf16* X2B; const bf16* U; float* OUT;
    struct In { u32x4 xw[2][2], uw[2][2]; };
    __device__ __forceinline__ void load(In& I, size_t base, int p, int wr, int fr) const {
#pragma unroll
        for (int q = 0; q < 2; ++q)
#pragma unroll
            for (int bj = 0; bj < 2; ++bj) { const size_t off = base + (size_t)GROUP_ROW(2 * p + q) * 1024 + 128 * bj; I.xw[q][bj] = *(const u32x4*)(X2B + off); I.uw[q][bj] = *(const u32x4*)(U + off); }
    }
    __device__ __forceinline__ void apply(const In& I, const f32x4 (&acc)[2][2][4][2], size_t base, int p, int wr, int fr) const {
#pragma unroll
        for (int q = 0; q < 2; ++q) { const int g = 2 * p + q, ai = g >> 2, m = g & 3; const int trow = GROUP_ROW(g); const float rs = rsl[trow];
#pragma unroll
            for (int bj = 0; bj < 2; ++bj) { f32x4 ua, ub, a, b; unpack8(I.uw[q][bj], ua, ub); unpack8(I.xw[q][bj], a, b);
#pragma unroll
                for (int j = 0; j < 4; ++j) { a[j] += sigm_c(acc[ai][bj][m][0][j] * rs) * ua[j]; b[j] += sigm_c(acc[ai][bj][m][1][j] * rs) * ub[j]; }
                float* o = OUT + base + (size_t)trow * 1024 + 128 * bj;
#if OUT_NT
                __builtin_nontemporal_store(a, (f32x4*)o); __builtin_nontemporal_store(b, (f32x4*)(o + 4)); } }
#else
                *(f32x4*)o = a; *(f32x4*)(o + 4) = b; } }
#endif
    }
    __device__ __forceinline__ void operator()(EPI_ARGS) const { EPI_OPAQUE();
        const size_t base = (size_t)u.pm * 256 * 1024 + u.pn * 256 + wc * 32 + 8 * fq;
        In A, B;
        load(A, base, 0, wr, fr); load(B, base, 1, wr, fr);
        apply(A, acc, base, 0, wr, fr); load(A, base, 2, wr, fr);
        apply(B, acc, base, 1, wr, fr); load(B, base, 3, wr, fr);
        apply(A, acc, base, 2, wr, fr);
        apply(B, acc, base, 3, wr, fr);
    }
};
struct EpiGate { const LAS float* rsl; unsigned (&st)[32];
    __device__ __forceinline__ void operator()(EPI_ARGS) const { EPI_OPAQUE();
#pragma unroll
        for (int g = 0; g < 8; ++g) { const float rs = rsl[GROUP_ROW(g)];
#pragma unroll
            for (int bj = 0; bj < 2; ++bj)
#pragma unroll
                for (int n = 0; n < 2; ++n) { f32x4 s;
#pragma unroll
                    for (int j = 0; j < 4; ++j) s[j] = 255.f * sigm_c(acc[g >> 2][bj][g & 3][n][j] * rs);
                    st[(g * 2 + bj) * 2 + n] = pack4_u8(s); } }
    }
};
struct EpiFinalU { const bf16* X2B; float* OUT; const unsigned (&st)[32];
    struct In { u32x4 xw[2][2]; };
    __device__ __forceinline__ void load(In& I, size_t base, int p, int wr, int fr) const {
#pragma unroll
        for (int q = 0; q < 2; ++q)
#pragma unroll
            for (int bj = 0; bj < 2; ++bj) I.xw[q][bj] = *(const u32x4*)(X2B + base + (size_t)GROUP_ROW(2 * p + q) * 1024 + 128 * bj);
    }
    __device__ __forceinline__ void apply(const In& I, const f32x4 (&acc)[2][2][4][2], size_t base, int p, int wr, int fr) const {
#pragma unroll
        for (int q = 0; q < 2; ++q) { const int g = 2 * p + q, ai = g >> 2, m = g & 3; const int trow = GROUP_ROW(g);
#pragma unroll
            for (int bj = 0; bj < 2; ++bj) { f32x4 a, b; unpack8(I.xw[q][bj], a, b);
                unsigned s0 = st[(g * 2 + bj) * 2 + 0], s1 = st[(g * 2 + bj) * 2 + 1]; asm volatile("" : "+v"(s0), "+v"(s1));
                const f32x4 ga = unpack4_u8(s0) * (1.f / 255.f), gb = unpack4_u8(s1) * (1.f / 255.f);
                a += ga * acc[ai][bj][m][0]; b += gb * acc[ai][bj][m][1];
                float* o = OUT + base + (size_t)trow * 1024 + 128 * bj; *(f32x4*)o = a; *(f32x4*)(o + 4) = b; } }
    }
    __device__ __forceinline__ void operator()(EPI_ARGS) const { EPI_OPAQUE();
        const size_t base = (size_t)u.pm * 256 * 1024 + u.pn * 256 + wc * 32 + 8 * fq;
        In A, B;
        load(A, base, 0, wr, fr); load(B, base, 1, wr, fr);
        apply(A, acc, base, 0, wr, fr); load(A, base, 2, wr, fr);
        apply(B, acc, base, 1, wr, fr); load(B, base, 3, wr, fr);
        apply(A, acc, base, 2, wr, fr);
        apply(B, acc, base, 3, wr, fr);
    }
};
struct SubsetOrder {
    int nM, nN, nwg, G, c, split, skip; unsigned A, Bt, tileA, tileB;
    __device__ void init(unsigned A_, unsigned pitchA, unsigned Bt_, unsigned pitchB, int M, int nN_, int split_, int skip_, int G_, int c_) { A = A_; Bt = Bt_; tileA = 256u * pitchA; tileB = 256u * pitchB; nM = M / 256; nN = nN_; nwg = nM * nN; G = G_; c = c_; split = split_; skip = skip_; }
    __device__ bool next(int i, Unit& u) const {
        const long L = (long)i * G + c; if (L >= nwg) return false;
        int wgid = (int)L; { const int q = nwg / 8, r = nwg % 8, xcd = wgid % 8, off = wgid / 8; wgid = (xcd < r ? xcd * (q + 1) : r * (q + 1) + (xcd - r) * q) + off; }
        const int nig = 8 * nN, gid = wgid / nig, fm = gid * 8, gsz = (nM - fm) < 8 ? (nM - fm) : 8;
        u.pm = fm + ((wgid % nig) % gsz); const int j = (wgid % nig) / gsz; u.pn = j < split ? j : j + skip;
        u.a = A + (unsigned)u.pm * tileA; u.b = Bt + (unsigned)j * tileB; u.rows = nullptr; u.nvalid = 256; u.e = 0; u.pos0 = 0; u.chain = 0; return true;
    }
};
struct MoeSched1 {
    int unit; const LAS int* ebase; const int* LIST; unsigned A, B, Z;
    __device__ __forceinline__ bool next(int j, Unit& u) const {
        if (unit >= 256) return false;
        const int T = unit >> 1, pn = unit & 1, g0 = T * 256, g1 = g0 + 255; int e0 = 0, e1 = 0;
#pragma unroll
        for (int k = 1; k < 16; ++k) { const int b = __builtin_amdgcn_readfirstlane(ebase[k]); e0 += (b <= g0) ? 1 : 0; e1 += (b <= g1) ? 1 : 0; }
        const int e = e0 + j; if (e > e1) return false;
        const int lo = __builtin_amdgcn_readfirstlane(ebase[e]), hi = __builtin_amdgcn_readfirstlane(ebase[e + 1]);
        u.pm = T; u.pn = pn; u.e = e; u.pos0 = 0; u.nvalid = 256; u.chain = (e < e1) ? 1 : 0;
        u.rlo = (lo > g0 ? lo : g0) - g0; u.rhi = (hi < g1 + 1 ? hi : g1 + 1) - g0;
        u.rows = LIST + (size_t)e * ECAP + (g0 - lo);
        u.a = A; u.zoff = Z - A; u.b = B + (unsigned)(e * 512 + pn * 256) * 1024u;
        return true;
    }
};
struct MoeSched2 {
    int unit; const LAS int* cbase; unsigned HID, WD, Z;
    __device__ __forceinline__ bool next(int j, Unit& u) const {
        if (unit >= 256) return false;
        const int T = unit >> 2, pn = unit & 3, g0 = T * 256, g1 = g0 + 255; int c0 = 0, c1 = 0;
#pragma unroll
        for (int k = 1; k < 24; ++k) { const int b = __builtin_amdgcn_readfirstlane(cbase[k]); c0 += (b <= g0) ? 1 : 0; c1 += (b <= g1) ? 1 : 0; }
        const int cls = c0 + (j >> 1), plane = j & 1; if (cls > c1) return false;
        const int lo = __builtin_amdgcn_readfirstlane(cbase[cls]), hi = __builtin_amdgcn_readfirstlane(cbase[cls + 1]);
        const int g = cls / 6, p = cls - 6 * g, elo = (p >= 3 ? 1 : 0) + (p >= 5 ? 1 : 0), ehi = p + 1 - (p >= 3 ? 2 : 0) - (p >= 5 ? 1 : 0), e = 4 * g + (plane ? ehi : elo);
        u.pm = T; u.pn = pn; u.e = cls; u.pos0 = 0; u.nvalid = 256; u.rows = nullptr; u.chain = (cls < c1 || plane == 0) ? 1 : 0;
        u.rlo = (lo > g0 ? lo : g0) - g0; u.rhi = (hi < g1 + 1 ? hi : g1 + 1) - g0;
        u.a = HID + (unsigned)((size_t)plane * HPLANE + (size_t)T * 256 * 256); u.zoff = Z - u.a; u.b = WD + (unsigned)(e * 1024 + pn * 256) * 256u;
        return true;
    }
};
#ifndef TH2_EXPR
#define TH2_EXPR (2.f * m2 + 23.f * LOG2E)
#endif
#ifndef NOSKIP
#define NOSKIP 0
#endif
#ifndef DEFER_WGU
#define DEFER_WGU 1
#endif
#ifndef OUT_NT
#define OUT_NT 0
#endif
#ifndef GROUPSYNC
#define GROUPSYNC 0
#endif
#ifndef DEFER_WD
#define DEFER_WD 2
#endif
#ifndef FUSE_U
#define FUSE_U 1
#endif
#ifndef REPBAR
#define REPBAR 0
#endif
#ifndef P0I_REP
#define P0I_REP 1
#endif
#ifndef P0X_REP
#define P0X_REP 1
#endif
#ifndef ATT_REP
#define ATT_REP 1
#endif
#ifndef P1_FP8
#define P1_FP8 1
#endif
#ifndef XTRA_BAR
#define XTRA_BAR 0
#endif
#ifndef REP_P7
#define REP_P7 1
#endif
#ifndef REP_P0
#define REP_P0 1
#endif
#ifndef REP_P1
#define REP_P1 1
#endif
#ifndef REP_P2
#define REP_P2 1
#endif
#ifndef REP_P3
#define REP_P3 1
#endif
#ifndef REP_P4
#define REP_P4 1
#endif
#ifndef REP_P6A
#define REP_P6A 1
#endif
#ifndef REP_P6B
#define REP_P6B 1
#endif

__global__ void __launch_bounds__(NWAVES * 64, 2) hybrid_fwd(Args args) {
    extern __shared__ __attribute__((aligned(16))) unsigned char lds[];
    Frame F;
    F.lds = (LAS unsigned char*)lds;
    F.MISC = (volatile LAS unsigned*)(F.lds + MISC_OFF);
    F.wave = __builtin_amdgcn_readfirstlane((int)threadIdx.x >> 6); F.lane = lane_id(); F.tid = F.wave * 64 + F.lane;
    F.G = gridDim.x; { const int bx = blockIdx.x; F.vcu = (F.G % 8 == 0) ? (bx % 8) * (F.G / 8) + bx / 8 : bx; }
    unsigned char* ws = args.ws;
    F.ctl = (gu32*)(ws + WS_CTL);
    typedef const __attribute__((address_space(4))) char* kptr_t;
    kptr_t kargs = (kptr_t)__builtin_amdgcn_kernarg_segment_ptr();
#define KIN(i) (*(const float* const __attribute__((address_space(4)))*)(kargs + 8 * (i)))
#define KFENCE() asm volatile("" : "+s"(kargs))
#define in_x KIN(0)
#define p_in KIN(1)
#define g_attn KIN(2)
#define w_in KIN(3)
#define b_f KIN(4)
#define gq KIN(5)
#define gk KIN(6)
#define conv_w KIN(7)
#define w_oa KIN(8)
#define w_oc KIN(9)
#define w_o KIN(10)
#define g_ffn KIN(11)
#define w_rg KIN(12)
#define b_rg KIN(13)
#define w_re KIN(14)
#define b_re KIN(15)
#define w_gate KIN(16)
#define w_up KIN(17)
#define w_down KIN(18)
#define g_ple KIN(19)
#define w_pg KIN(20)
#define w_ple KIN(21)
    float* out = args.out;
    bf16* WIN = (bf16*)(ws + WS_WIN); bf16* WAB = (bf16*)(ws + WS_WAB); bf16* WO = (bf16*)(ws + WS_WO); bf16* WGU = (bf16*)(ws + WS_WGU); bf16* WD = (bf16*)(ws + WS_WD);
    bf16* WPG = (bf16*)(ws + WS_WPG); bf16* WPLE = (bf16*)(ws + WS_WPLE); bf16* WR = (bf16*)(ws + WS_WR);
    float* RSTD1 = (float*)(ws + WS_RSTD1); float* LF = (float*)(ws + WS_LF); float* CC = (float*)(ws + WS_C); float* SSQ2 = (float*)(ws + WS_SSQ2);
    float* RSTD2 = (float*)(ws + WS_RSTD2); int* LIST = (int*)(ws + WS_LIST); float* GATE = (float*)(ws + WS_GATE); int* INFO = (int*)(ws + WS_INFO); int* CLIST = (int*)(ws + WS_CLIST); float* SSQ3 = (float*)(ws + WS_SSQ3);
    bf16* XB = (bf16*)(ws + WS_XB); bf16* ACAT = (bf16*)(ws + WS_ACAT); bf16* HIDP = (bf16*)(ws + WS_HIDP);
    bf16* QB_ = (bf16*)(ws + WS_Q); bf16* KB_ = (bf16*)(ws + WS_K); bf16* VB_ = (bf16*)(ws + WS_V); bf16* MG = (bf16*)(ws + WS_MG); bf16* X1B = (bf16*)(ws + WS_X1B);
    bf16* CCU = (bf16*)(ws + WS_CCU); bf16* CB = (bf16*)(ws + WS_CB); bf16* UB = (bf16*)(ws + WS_U); bf16* RB = (bf16*)(ws + WS_R); bf16* SGB = (bf16*)(ws + WS_SGB);
    bf16* X2B = (bf16*)(ws + WS_X2B); bf16* PB = (bf16*)(ws + WS_PB); unsigned char* WIN8 = ws + WS_WIN8; unsigned char* XB8 = ws + WS_XB8; unsigned char* X1B8 = ws + WS_X1B8; unsigned char* X2B8 = ws + WS_X2B8;

    const wsrc_t WSR = __builtin_amdgcn_make_buffer_rsrc((void*)ws, (short)0, (int)WS_END, 0x00020000);
    for (int u = F.tid; u < (LDS_BYTES - LDSCTL_OFF) / 4; u += NWAVES * 64) ((LAS unsigned*)(F.lds + LDSCTL_OFF))[u] = 0u;
    __syncthreads();
    XcdBarrier bar = xcd_barrier_post((unsigned*)(F.ctl + CW_BAR), F.MISC + 8, F.tid);
#if CODE_PF && CODE_PF_ENTRY
    if (F.wave == 1 || F.wave == 2) {
        unsigned long long pc_; asm volatile("s_getpc_b64 %0" : "=s"(pc_));
        const unsigned long long a_ = (pc_ & ~255ULL) + (unsigned long long)((blockIdx.x >> 3) & 31u) * 1024u + (unsigned)(F.wave - 1) * 32768u / 2u * 0u + (unsigned)F.lane * 16u + (F.wave == 2 ? 32768u : 0u);
        __builtin_amdgcn_global_load_lds((const __attribute__((address_space(1))) void*)a_, (LAS void*)(F.lds + CODE_PF_DUMP + (F.wave - 1) * 1024), 16, 0, 0);
    }
#endif
#define REFRESH() do { int t_ = lane_id(); asm volatile("" : "+v"(t_)); F.lane = t_; F.tid = F.wave * 64 + t_; } while (0)
#ifdef PROBE_K
#define STAMP() do { if (blockIdx.x == 0 && F.tid == 0) { TSB[n_stamp] = rt(); } ++n_stamp; } while (0)
#else
#define STAMP() do {} while (0)
#endif
#ifdef TP_BAR
#ifndef TP_MODE
#define TP_MODE 0
#endif
#define TP_SPIN_() do { if (F.wave * 64 + lane_id() == 0) { LAS unsigned long long* tp_ = (LAS unsigned long long*)(F.lds + (LDS_BYTES - 64)); const unsigned long long now_ = rt(); const unsigned long long d_ = now_ - *tp_; while (rt() - now_ < d_) __builtin_amdgcn_s_sleep(4); } __syncthreads(); } while (0)
#define TP_WSPIN_() do { if (lane_id() == 0) { LAS unsigned long long* tp_ = (LAS unsigned long long*)(F.lds + (LDS_BYTES - 64)); const unsigned long long now_ = rt(); const unsigned long long d_ = now_ - *tp_; while (rt() - now_ < d_) __builtin_amdgcn_s_sleep(4); } } while (0)
#define TP_MARK() do { ++nb_; if (nb_ == TP_BAR - 1) { if (F.wave * 64 + lane_id() == 0) *(LAS unsigned long long*)(F.lds + (LDS_BYTES - 64)) = rt(); __syncthreads(); } else if (TP_MODE == 0 && nb_ == TP_BAR) TP_SPIN_(); } while (0)
#ifndef TP_SUBSET
#define TP_SUBSET 0
#endif
#define TP_INSUB_ (TP_SUBSET == 0 || (TP_SUBSET == 1 && blockIdx.x >= 128) || (TP_SUBSET == 2 && blockIdx.x >= 32 && blockIdx.x < 128) || (TP_SUBSET == 3 && blockIdx.x < 32))
#define TP_PRE() do { if (TP_MODE == 1 && nb_ + 1 == TP_BAR && TP_INSUB_) { __syncthreads(); TP_SPIN_(); } } while (0)
#else
#define TP_MARK() do {} while (0)
#define TP_PRE() do {} while (0)
#endif
#define GRID_BAR() do { TP_PRE(); xcd_barrier(bar, F.wave * 64 + lane_id()); TP_MARK(); KFENCE(); REFRESH(); STAMP(); } while (0)
#define GROUP_ARRIVE(word_) do { VM_WAIT(); __syncthreads(); if (F.wave * 64 + lane_id() == 0) { __builtin_amdgcn_fence(__ATOMIC_RELEASE, "agent"); VM_WAIT(); (void)xb_add((unsigned*)(F.ctl + (word_)), 1u); } } while (0)
#define GROUP_WAIT(word_, n_) do { if (F.wave * 64 + lane_id() == 0) { unsigned* w_ = (unsigned*)(F.ctl + (word_)); XB_SPIN(xb_ld(w_) < (unsigned)(n_), bar.bar); __builtin_amdgcn_fence(__ATOMIC_ACQUIRE, "agent"); VM_WAIT(); } __syncthreads(); KFENCE(); REFRESH(); } while (0)
    const int gw = F.vcu * NWAVES + F.wave, NGW = F.G * NWAVES;
#ifdef PROBE_K
    unsigned long long* TSB = (unsigned long long*)(ws + WS_RSTD3 + 128 * 1024); int n_stamp = 0; STAMP();
#endif
    const int NGT = F.G * NWAVES * 64;
#ifdef TP_BAR
    int nb_ = -1; TP_MARK();
#endif
#define gt (F.vcu * (NWAVES * 64) + F.tid)

    for (int xb_ = 0; xb_ < XTRA_BAR; ++xb_) GRID_BAR();
    for (int rep_ = 0; rep_ < REP_P0; ++rep_) {
    {
        LAS float* scr = (LAS float*)(F.lds + RING_OFF + F.wave * 16384);
        constexpr int I_WIN = 16 * 160, I_WAB = 16 * 32, I_WO = 16 * 32, I_WGU = 16 * 16 * 16, I_WD = 16 * 4 * 32, I_WPG = 16 * 32, I_WPLE = 4 * 32;
        constexpr int NITEMS = I_WIN + I_WAB + I_WO + I_WGU + I_WD + I_WPG + I_WPLE;
        struct Item { const float* src; const float* g; bf16* dst; int ld, Kd, drow, kd0, f8; float sc; unsigned char* dst8; };
        auto decode = [&](int it, Item& I) {
            int r = it;
            I.f8 = 0; I.sc = 32.f; I.dst8 = WIN8;
            if (r < I_WIN) { const int kb = r / 160, ng = r % 160, pn = ng >> 3; I.src = w_in + (size_t)(64 * kb) * PW_ + win_scol(ng); I.ld = PW_; I.g = g_attn + 64 * kb; I.dst = WIN; I.Kd = 1024; I.drow = ng * 32; I.kd0 = 64 * kb;
                if (P1_FP8 && (pn < 6 || pn >= 12)) { I.f8 = 1; I.drow = (pn < 6 ? pn : pn - 6) * 256 + (ng & 7) * 32; }
                return; } r -= I_WIN;
            if (r < I_WAB) { const int kb = r / 32, ng = r % 32; I.src = ((kb < 8) ? w_oa + (size_t)(64 * kb) * 1024 : w_oc + (size_t)(64 * (kb - 8)) * 1024) + 32 * ng; I.ld = 1024; I.g = nullptr; I.dst = WAB; I.Kd = 1024; I.drow = ng * 32; I.kd0 = 64 * kb; return; } r -= I_WAB;
            if (r < I_WO) { const int kb = r / 32, ng = r % 32; I.src = w_o + (size_t)(64 * kb) * 1024 + 32 * ng; I.ld = 1024; I.g = nullptr; I.dst = WO; I.Kd = 1024; I.drow = ng * 32; I.kd0 = 64 * kb; return; } r -= I_WO;
            if (r < I_WGU) { const int e = r / 256, kb = (r % 256) / 16, ng = r % 16, nt = ng >> 3, gidx = ng & 7, bj = gidx >> 2, wcc = gidx & 3;
                I.src = (bj ? w_up : w_gate) + (size_t)e * 1024 * 256 + (size_t)(64 * kb) * 256 + nt * 128 + 32 * wcc; I.ld = 256; I.g = g_ffn + 64 * kb; I.dst = WGU; I.f8 = 1; I.dst8 = (unsigned char*)WGU + (size_t)e * 512 * 1024; I.Kd = 1024; I.drow = ng * 32; I.kd0 = 64 * kb; return; } r -= I_WGU;
            if (r < I_WD) { const int e = r / 128, kb = (r % 128) / 32, ng = r % 32;
                I.src = w_down + (size_t)e * 256 * 1024 + (size_t)(64 * kb) * 1024 + 32 * ng; I.ld = 1024; I.g = nullptr; I.dst = WD; I.f8 = 1; I.sc = 16.f; I.dst8 = (unsigned char*)WD + (size_t)e * 1024 * 256; I.Kd = 256; I.drow = ng * 32; I.kd0 = 64 * kb; return; } r -= I_WD;
            if (r < I_WPG) { const int kb = r / 32, ng = r % 32; I.src = w_pg + (size_t)(64 * kb) * 1024 + 32 * ng; I.ld = 1024; I.g = g_ple + 64 * kb; I.dst = WPG; I.f8 = 1; I.dst8 = (unsigned char*)WPG; I.Kd = 1024; I.drow = ng * 32; I.kd0 = 64 * kb; return; } r -= I_WPG;
            { const int kb = r / 32, ng = r % 32; I.src = w_ple + (size_t)(64 * kb) * 1024 + 32 * ng; I.ld = 1024; I.g = nullptr; I.dst = WPLE; I.Kd = 256; I.drow = ng * 32; I.kd0 = 64 * kb; }
        };
        LAS unsigned char* wfh = F.lds + RING_OFF;
        for (int k = F.tid; k < 1024; k += NWAVES * 64) {
            const float* wp = w_in + (size_t)k * PW_ + OFF_F; const f32x4 w0 = *(const f32x4*)wp, w1 = *(const f32x4*)(wp + 4); const float g = g_attn[k];
            LAS unsigned char* d = wfh + (k >> 5) * 512 + ((k >> 3) & 3) * 128 + (k & 7) * 2;
#pragma unroll
            for (int h = 0; h < 8; ++h) { const float w = (h < 4 ? w0[h & 3] : w1[h & 3]) * g; const unsigned hi = f2bf(w); const unsigned lo = f2bf(w - __uint_as_float(hi << 16));
                *(LAS unsigned short*)(d + h * 16) = (unsigned short)hi; *(LAS unsigned short*)(d + 16384 + h * 16) = (unsigned short)lo; } }
        if (gt < 256) ((unsigned*)(ws + WS_ZERO))[gt] = 0u;
        for (int i = gt; i < 32 * 1024; i += NGT) { const int n = i >> 10, k = i & 1023; float v = 0.f;
            if (n < 4) v = w_rg[k * 4 + n] * g_ffn[k]; else if (n < 20) v = w_re[k * 16 + (n - 4)] * g_ffn[k];
            WR[i] = (bf16)f2bf(v); }
        __syncthreads();
#if defined(TP_BAR) && defined(TP_P0)
        if (TP_P0 == 1) { TP_SPIN_(); }
#endif
        if (F.wave < 4) {
            const int fr = F.lane & 15, fq = F.lane >> 4;
            const int row = (int)blockIdx.x * 64 + F.wave * 16 + fr;
            const float* xp = in_x + (size_t)row * 1024 + 8 * fq;
            const LAS unsigned char* wl = wfh + fq * 128 + (fr & 7) * 16;
            bf16* xbo = XB + (size_t)row * 1024 + 8 * fq; unsigned char* x8o = XB8 + (size_t)row * 1024 + 8 * fq;
            f32x4 acc = (f32x4){0.f, 0.f, 0.f, 0.f}; float ssq = 0.f;
            f32x4 va[8][2], vb[8][2];
#define XLOAD(dst, c_) do { _Pragma("unroll") for (int s_ = 0; s_ < 8; ++s_) { dst[s_][0] = *(const f32x4*)(xp + 32 * (8 * (c_) + s_)); dst[s_][1] = *(const f32x4*)(xp + 32 * (8 * (c_) + s_) + 4); } } while (0)
#define XPROC(src, c_) do { _Pragma("unroll") for (int s_ = 0; s_ < 8; ++s_) { const int ks_ = 8 * (c_) + s_; const f32x4 x0 = src[s_][0], x1 = src[s_][1]; \
                ssq += ((x0[0] * x0[0] + x0[1] * x0[1]) + (x0[2] * x0[2] + x0[3] * x0[3])) + ((x1[0] * x1[0] + x1[1] * x1[1]) + (x1[2] * x1[2] + x1[3] * x1[3])); \
                u32x4 hw; hw.x = cvt_pk_bf16(x0[0], x0[1]); hw.y = cvt_pk_bf16(x0[2], x0[3]); hw.z = cvt_pk_bf16(x1[0], x1[1]); hw.w = cvt_pk_bf16(x1[2], x1[3]); \
                u32x4 lw; lw.x = cvt_pk_bf16(x0[0] - bf_lo(hw.x), x0[1] - bf_hi(hw.x)); lw.y = cvt_pk_bf16(x0[2] - bf_lo(hw.y), x0[3] - bf_hi(hw.y)); \
                lw.z = cvt_pk_bf16(x1[0] - bf_lo(hw.z), x1[1] - bf_hi(hw.z)); lw.w = cvt_pk_bf16(x1[2] - bf_lo(hw.w), x1[3] - bf_hi(hw.w)); \
                const bf16x8 ah = *(const LAS bf16x8*)(wl + ks_ * 512), al = *(const LAS bf16x8*)(wl + 16384 + ks_ * 512); const bf16x8 xh = __builtin_bit_cast(bf16x8, hw), xl = __builtin_bit_cast(bf16x8, lw); \
                acc = __builtin_amdgcn_mfma_f32_16x16x32_bf16(ah, xh, acc, 0, 0, 0); acc = __builtin_amdgcn_mfma_f32_16x16x32_bf16(al, xh, acc, 0, 0, 0); acc = __builtin_amdgcn_mfma_f32_16x16x32_bf16(ah, xl, acc, 0, 0, 0); \
                *(u32x4*)(xbo + 32 * ks_) = hw; \
                int w0_ = __builtin_amdgcn_cvt_pk_fp8_f32(x0[0], x0[1], 0, false); w0_ = __builtin_amdgcn_cvt_pk_fp8_f32(x0[2], x0[3], w0_, true); \
                int w1_ = __builtin_amdgcn_cvt_pk_fp8_f32(x1[0], x1[1], 0, false); w1_ = __builtin_amdgcn_cvt_pk_fp8_f32(x1[2], x1[3], w1_, true); \
                *(pg8::u32x2*)(x8o + 32 * ks_) = (pg8::u32x2){(unsigned)w0_, (unsigned)w1_}; } } while (0)
            XLOAD(va, 0); XLOAD(vb, 1);
            XPROC(va, 0); XLOAD(va, 2);
            XPROC(vb, 1); XLOAD(vb, 3);
            XPROC(va, 2);
            XPROC(vb, 3);
#undef XLOAD
#undef XPROC
            ssq = xor16_add(ssq); ssq = xor32_add(ssq);
            const float rstd = 1.f / sqrtf(ssq * (1.f / 1024.f) + EPS_);
            if (fq == 0) RSTD1[row] = rstd;
            if (fq < 2) {
#pragma unroll
                for (int r = 0; r < 4; ++r) { const int h = 4 * fq + r; const float z = acc[r] * rstd + b_f[h]; const float ls = fminf(z, 0.f) - log1pf(expf(-fabsf(z)));
                    LF[((size_t)(row >> 12) * 8 + h) * SEQ_ + (row & (SEQ_ - 1))] = ls; } }
#if defined(TP_BAR) && defined(TP_P0)
            if (TP_P0 == 3) { VM_WAIT(); TP_WSPIN_(); }
#endif
        } else {
        const int n4 = 4 * (F.lane & 7), k8 = F.lane >> 3;
        const int igw = F.vcu * 4 + (F.wave - 4), INGW = F.G * 4;
        Item cur; f32x4 va[8], vb[8]; float ga[8], gb[8];
        {
        constexpr int SKIP_AT = I_WIN + I_WAB + I_WO;
#define ITEM_ID(i_) ((i_) < SKIP_AT ? (i_) : (i_) + (DEFER_WGU ? I_WGU : 0) + (DEFER_WD ? I_WD : 0))
#define NITEMS_P0 (NITEMS - (DEFER_WGU ? I_WGU : 0) - (DEFER_WD ? I_WD + I_WPLE : 0))
        int it = igw;
        if (it < NITEMS_P0) { decode(ITEM_ID(it), cur);
#pragma unroll
            for (int i = 0; i < 8; ++i) { va[i] = *(const f32x4*)(cur.src + (size_t)(k8 + 8 * i) * cur.ld + n4); ga[i] = cur.g ? cur.g[k8 + 8 * i] : 1.f; } }
        while (it < NITEMS_P0) {
            const int itn = it + INGW; Item nx = cur;
            if (itn < NITEMS_P0) { decode(ITEM_ID(itn), nx);
#pragma unroll
                for (int i = 0; i < 8; ++i) { vb[i] = *(const f32x4*)(nx.src + (size_t)(k8 + 8 * i) * nx.ld + n4); gb[i] = nx.g ? nx.g[k8 + 8 * i] : 1.f; } }
#pragma unroll
            for (int i = 0; i < 8; ++i) { LAS float* d = scr + (k8 + 8 * i) * 33 + n4; const f32x4 v = va[i] * ga[i]; d[0] = v[0]; d[1] = v[1]; d[2] = v[2]; d[3] = v[3]; }
            LDS_WAIT(); asm volatile("" ::: "memory");
            { const int c = F.lane & 7;
#pragma unroll
              for (int j = 0; j < 4; ++j) { const int n = (F.lane >> 3) + 8 * j; const LAS float* s = scr + (8 * c) * 33 + n;
                if (cur.f8) { const float sc = cur.sc; int w0 = __builtin_amdgcn_cvt_pk_fp8_f32(s[0 * 33] * sc, s[1 * 33] * sc, 0, false); w0 = __builtin_amdgcn_cvt_pk_fp8_f32(s[2 * 33] * sc, s[3 * 33] * sc, w0, true);
                    int w1 = __builtin_amdgcn_cvt_pk_fp8_f32(s[4 * 33] * sc, s[5 * 33] * sc, 0, false); w1 = __builtin_amdgcn_cvt_pk_fp8_f32(s[6 * 33] * sc, s[7 * 33] * sc, w1, true);
                    *(unsigned long long*)(cur.dst8 + (size_t)(cur.drow + n) * cur.Kd + cur.kd0 + 8 * c) = (unsigned long long)(unsigned)w0 | ((unsigned long long)(unsigned)w1 << 32); }
                else { v4u o; o.x = pk2(s[0 * 33], s[1 * 33]); o.y = pk2(s[2 * 33], s[3 * 33]); o.z = pk2(s[4 * 33], s[5 * 33]); o.w = pk2(s[6 * 33], s[7 * 33]);
                    WTS(WSR, (unsigned)((const char*)(cur.dst + (size_t)(cur.drow + n) * cur.Kd + cur.kd0 + 8 * c) - (const char*)ws), o); } } }
            LDS_WAIT(); asm volatile("" ::: "memory");
            cur = nx; it = itn;
#pragma unroll
            for (int i = 0; i < 8; ++i) { va[i] = vb[i]; ga[i] = gb[i]; }
        }
        }
        for (int m = igw * 4; m < NTOK; m += INGW * 4) { f32x4 pv[4];
#pragma unroll
            for (int j = 0; j < 4; ++j) pv[j] = *((const f32x4*)(p_in + (size_t)(m + j) * 256) + F.lane);
#pragma unroll
            for (int j = 0; j < 4; ++j) *((unsigned long long*)(PB + (size_t)(m + j) * 256) + F.lane) = (unsigned long long)pk2(pv[j][0], pv[j][1]) | ((unsigned long long)pk2(pv[j][2], pv[j][3]) << 32); }
#if defined(TP_BAR) && defined(TP_P0)
            if (TP_P0 == 4) { VM_WAIT(); TP_WSPIN_(); }
#endif
        }
    }
    __syncthreads(); }
    GRID_BAR();
    if (blockIdx.x < NB_ * NH_) {
        const int bh = blockIdx.x; const float* lf = LF + (size_t)bh * SEQ_ + F.tid * 8; float v[8]; float s = 0.f;
        const f32x4 a = *(const f32x4*)lf, b = *(const f32x4*)(lf + 4);
        v[0] = a[0]; v[1] = a[1]; v[2] = a[2]; v[3] = a[3]; v[4] = b[0]; v[5] = b[1]; v[6] = b[2]; v[7] = b[3];
#pragma unroll
        for (int j = 0; j < 8; ++j) { s += v[j]; v[j] = s; }
        float incl = s;
#pragma unroll
        for (int o = 1; o < 64; o <<= 1) { const float t = __shfl_up(incl, o); if (F.lane >= o) incl += t; }
        LAS float* wt = (LAS float*)(F.lds + RING_OFF);
        if (F.lane == 63) wt[F.wave] = incl;
        __syncthreads();
        float base = incl - s;
        for (int w = 0; w < F.wave; ++w) base += wt[w];
        float* co = CC + (size_t)bh * SEQ_ + F.tid * 8;
        *(f32x4*)co = (f32x4){base + v[0], base + v[1], base + v[2], base + v[3]}; *(f32x4*)(co + 4) = (f32x4){base + v[4], base + v[5], base + v[6], base + v[7]};
    }
    __syncthreads();
    for (int rep_ = 0; rep_ < REP_P1; ++rep_) {
    {
#if P1_FP8
        { SubsetOrder S; S.init((unsigned)WS_XB8, 1024u, (unsigned)WS_WIN8, 1024u, NTOK, 14, 6, 6, F.G, (int)blockIdx.x);
          EpiP1 E{RSTD1, gq, gk, WSR, (unsigned)WS_Q, (unsigned)WS_K, (unsigned)WS_V, (unsigned)WS_CCU, (unsigned)WS_CB, ws + WS_R, ws + WS_SGB, 1.f / 32.f};
          pg8::gemm_phase<EpiP1, SubsetOrder, true, 0, false, true>(F.lds + RING_OFF, WSR, F.wave, 1024, S, E); }
        { SubsetOrder S; S.init((unsigned)WS_XB, 2048u, (unsigned)(WS_WIN + (size_t)6 * 256 * 2048), 2048u, NTOK, 6, 0, 6, F.G, (int)(((blockIdx.x & ~7u) ^ (unsigned)(F.G - 8)) | (blockIdx.x & 7u)));
          EpiP1 E{RSTD1, gq, gk, WSR, (unsigned)WS_Q, (unsigned)WS_K, (unsigned)WS_V, (unsigned)WS_CCU, (unsigned)WS_CB, ws + WS_R, ws + WS_SGB, 1.f};
          pg8::gemm_phase<EpiP1, SubsetOrder, true, 0, false, false>(F.lds + RING_OFF, WSR, F.wave, 1024, S, E); }
#else
        { SubsetOrder S; S.init((unsigned)WS_XB, 2048u, (unsigned)WS_WIN, 2048u, NTOK, 20, 20, 0, F.G, (int)blockIdx.x);
          EpiP1 E{RSTD1, gq, gk, WSR, (unsigned)WS_Q, (unsigned)WS_K, (unsigned)WS_V, (unsigned)WS_CCU, (unsigned)WS_CB, ws + WS_R, ws + WS_SGB, 1.f};
          pg8::gemm_phase<EpiP1, SubsetOrder, true, 0, false, false>(F.lds + RING_OFF, WSR, F.wave, 1024, S, E); }
#endif
#if DEFER_WGU
        if (blockIdx.x < 128) {
            LAS float* scr = (LAS float*)(F.lds + RING_OFF + F.wave * 16384);
            const int lane = lane_id(), n4 = 4 * (lane & 7), k8 = lane >> 3, c8 = lane & 7;
            f32x4 v[4][8]; float gs[4][8];
#pragma unroll
            for (int q = 0; q < 4; ++q) { const int r = (int)blockIdx.x * NWAVES + F.wave + q * (128 * NWAVES);
                const int e = r >> 8, kb = (r >> 4) & 15, ng = r & 15, nt = ng >> 3, gidx = ng & 7, bj = gidx >> 2, wcc = gidx & 3;
                const float* src = (bj ? w_up : w_gate) + (size_t)e * 1024 * 256 + (size_t)(64 * kb) * 256 + nt * 128 + 32 * wcc; const float* gg = g_ffn + 64 * kb;
#pragma unroll
                for (int i = 0; i < 8; ++i) { v[q][i] = *(const f32x4*)(src + (size_t)(k8 + 8 * i) * 256 + n4); gs[q][i] = gg[k8 + 8 * i] * 32.f; } }
#pragma unroll
            for (int q = 0; q < 4; ++q) { const int r = (int)blockIdx.x * NWAVES + F.wave + q * (128 * NWAVES);
                const int e = r >> 8, kb = (r >> 4) & 15, ng = r & 15;
#pragma unroll
                for (int i = 0; i < 8; ++i) { LAS float* d = scr + (k8 + 8 * i) * 33 + n4; const f32x4 w = v[q][i] * gs[q][i]; d[0] = w[0]; d[1] = w[1]; d[2] = w[2]; d[3] = w[3]; }
                LDS_WAIT(); asm volatile("" ::: "memory");
                unsigned char* dst = (unsigned char*)WGU + (size_t)e * 512 * 1024 + (size_t)(ng * 32) * 1024 + 64 * kb + 8 * c8;
#pragma unroll
                for (int j = 0; j < 4; ++j) { const int n = (lane >> 3) + 8 * j; const LAS float* s = scr + (8 * c8) * 33 + n;
                    int w0 = __builtin_amdgcn_cvt_pk_fp8_f32(s[0 * 33], s[1 * 33], 0, false); w0 = __builtin_amdgcn_cvt_pk_fp8_f32(s[2 * 33], s[3 * 33], w0, true);
                    int w1 = __builtin_amdgcn_cvt_pk_fp8_f32(s[4 * 33], s[5 * 33], 0, false); w1 = __builtin_amdgcn_cvt_pk_fp8_f32(s[6 * 33], s[7 * 33], w1, true);
                    *(unsigned long long*)(dst + (size_t)n * 1024) = (unsigned long long)(unsigned)w0 | ((unsigned long long)(unsigned)w1 << 32); }
                LDS_WAIT(); asm volatile("" ::: "memory");
            }
#if DEFER_WD == 2
            {
            constexpr int NIT = 16 * 4 * 32 + 4 * 32;
            f32x4 v2[3][8];
#pragma unroll
            for (int q = 0; q < 3; ++q) { const int r = (int)blockIdx.x * NWAVES + F.wave + q * 1024;
                if (r < NIT) { const bool ple = r >= 16 * 4 * 32; const int qq = ple ? r - 16 * 4 * 32 : r, e = qq >> 7, kb = (qq >> 5) & 3, ng = qq & 31;
                    const float* src = (ple ? w_ple : w_down + (size_t)e * 256 * 1024) + (size_t)(64 * kb) * 1024 + 32 * ng;
#pragma unroll
                    for (int i = 0; i < 8; ++i) v2[q][i] = *(const f32x4*)(src + (size_t)(k8 + 8 * i) * 1024 + n4); } }
#pragma unroll
            for (int q = 0; q < 3; ++q) { const int r = (int)blockIdx.x * NWAVES + F.wave + q * 1024;
                if (r < NIT) { const bool ple = r >= 16 * 4 * 32; const int qq = ple ? r - 16 * 4 * 32 : r, e = qq >> 7, kb = (qq >> 5) & 3, ng = qq & 31;
                const float sc = ple ? 1.f : 16.f;
#pragma unroll
                for (int i = 0; i < 8; ++i) { LAS float* d = scr + (k8 + 8 * i) * 33 + n4; const f32x4 w = v2[q][i] * sc; d[0] = w[0]; d[1] = w[1]; d[2] = w[2]; d[3] = w[3]; }
                LDS_WAIT(); asm volatile("" ::: "memory");
#pragma unroll
                for (int j = 0; j < 4; ++j) { const int n = (lane >> 3) + 8 * j; const LAS float* s = scr + (8 * c8) * 33 + n;
                    if (ple) { v4u o; o.x = pk2(s[0 * 33], s[1 * 33]); o.y = pk2(s[2 * 33], s[3 * 33]); o.z = pk2(s[4 * 33], s[5 * 33]); o.w = pk2(s[6 * 33], s[7 * 33]);
                        *(v4u*)(WPLE + (size_t)(ng * 32 + n) * 256 + 64 * kb + 8 * c8) = o; }
                    else { int w0 = __builtin_amdgcn_cvt_pk_fp8_f32(s[0 * 33], s[1 * 33], 0, false); w0 = __builtin_amdgcn_cvt_pk_fp8_f32(s[2 * 33], s[3 * 33], w0, true);
                        int w1 = __builtin_amdgcn_cvt_pk_fp8_f32(s[4 * 33], s[5 * 33], 0, false); w1 = __builtin_amdgcn_cvt_pk_fp8_f32(s[6 * 33], s[7 * 33], w1, true);
                        *(unsigned long long*)((unsigned char*)WD + (size_t)e * 1024 * 256 + (size_t)(ng * 32 + n) * 256 + 64 * kb + 8 * c8) = (unsigned long long)(unsigned)w0 | ((unsigned long long)(unsigned)w1 << 32); } }
                LDS_WAIT(); asm volatile("" ::: "memory");
                } }
            }
#endif
        }
#endif
    }
    __syncthreads(); }
    GRID_BAR();
    for (int rep_ = 0; rep_ < REP_P2; ++rep_) {
    for (int g2 = gt; g2 < (NTOK / 8) * 64; g2 += NGT) {
        const int ch0 = (g2 & 63) * 8, t0 = (g2 >> 6) * 8; const bool first = (t0 & (SEQ_ - 1)) == 0;
        const u32x4 z4 = (u32x4){0u, 0u, 0u, 0u};
        u32x4 cu[10], cv[8];
        cu[0] = first ? z4 : *(const u32x4*)(CCU + (size_t)(t0 - 2) * 512 + ch0); cu[1] = first ? z4 : *(const u32x4*)(CCU + (size_t)(t0 - 1) * 512 + ch0);
#pragma unroll
        for (int i = 0; i < 8; ++i) { cu[2 + i] = *(const u32x4*)(CCU + (size_t)(t0 + i) * 512 + ch0); cv[i] = *(const u32x4*)(CB + (size_t)(t0 + i) * 512 + ch0); }
        const f32x4 w0a = *(const f32x4*)(conv_w + ch0), w0b = *(const f32x4*)(conv_w + ch0 + 4), w1a = *(const f32x4*)(conv_w + 512 + ch0), w1b = *(const f32x4*)(conv_w + 512 + ch0 + 4),
                    w2a = *(const f32x4*)(conv_w + 1024 + ch0), w2b = *(const f32x4*)(conv_w + 1024 + ch0 + 4);
        f32x4 u0a, u0b, u1a, u1b; unpack8(cu[0], u0a, u0b); unpack8(cu[1], u1a, u1b);
#pragma unroll
        for (int i = 0; i < 8; ++i) { f32x4 u2a, u2b, ca, cb_; unpack8(cu[2 + i], u2a, u2b); unpack8(cv[i], ca, cb_);
            WTS(WSR, (unsigned)WS_ACAT + (unsigned)((size_t)(t0 + i) * 1024 + 512 + ch0) * 2u, pack8(ca * (w0a * u0a + w1a * u1a + w2a * u2a), cb_ * (w0b * u0b + w1b * u1b + w2b * u2b)));
            u0a = u1a; u0b = u1b; u1a = u2a; u1b = u2b; }
    }
    {
        float mq = 0.f, mk = 0.f;
        for (int i = 0; i < 64; ++i) { mq = fmaxf(mq, fabsf(gq[i])); mk = fmaxf(mk, fabsf(gk[i])); }
        const float m2 = QC2 * 64.f * mq * mk, th2 = TH2_EXPR;
        LAS float* cE = (LAS float*)(F.lds + RING_OFF + attn_body::LDS_BYTES);
        LAS int* ucost = (LAS int*)(F.lds + RING_OFF + attn_body::LDS_BYTES + 8192);
        LAS int* bhc = ucost + 512;
        LAS int* nj = bhc + 32;
        LAS int* sj = nj + 16;
        for (int i = F.tid; i < 2048; i += NWAVES * 64) cE[i] = CC[(size_t)(i >> 6) * SEQ_ + (i & 63) * 64 + 63];
        if (F.tid < 32) bhc[F.tid] = 0;
        __syncthreads();
        { const int uid = F.tid, bh = uid >> 4, qb = uid & 15, NT = 4 * (qb + 1);
          const float cq0 = CC[(size_t)bh * SEQ_ + qb * 256]; int t0 = 0;
          for (int j = 0; j < NT - 4; ++j) { if ((cq0 - cE[bh * 64 + j]) * LOG2E < -th2) t0 = j + 1; }
          t0 &= ~1; if (NOSKIP) t0 = 0; ucost[uid] = ((NT - t0) << 8) | t0;
          __hip_atomic_fetch_add(bhc + bh, NT - t0 + 5, __ATOMIC_RELAXED, __HIP_MEMORY_SCOPE_WORKGROUP); }
        __syncthreads();
        if (F.tid < 32) { const int mine = bhc[F.tid]; int rank = 0;
            for (int j = 0; j < 32; ++j) { const int o = bhc[j]; rank += (o > mine || (o == mine && j < F.tid)) ? 1 : 0; }
            sj[rank] = F.tid; }
        __syncthreads();
        LAS float* ct = (LAS float*)(F.lds + RING_OFF + attn_body::LDS_CT);
        const int slot = F.vcu >> 4, me = F.vcu & 15;
        for (int kk = 0; kk < 2 * ATT_REP; ++kk) { const int k = kk & 1;
            const int bh = __builtin_amdgcn_readfirstlane(sj[k ? 31 - slot : slot]), qb = (k & 1) ? 15 - me : me, t0 = __builtin_amdgcn_readfirstlane(ucost[bh * 16 + qb]) & 255;
            { const int t_ = F.wave * 64 + lane_id();
              for (int i = t_; i < SEQ_; i += NWAVES * 64) ct[i] = -CC[(size_t)bh * SEQ_ + i] * LOG2E; }
            __syncthreads();
            attn_body::attn_unit(bh >> 3, bh & 7, qb, t0, m2, (const attn_body::bf16*)QB_, (const attn_body::bf16*)KB_, (const attn_body::bf16*)VB_, (attn_body::bf16*)ACAT, (char*)lds + RING_OFF, WSR, (const char*)ws, F.wave);
        }
    }
    __syncthreads(); }
    GRID_BAR();
    for (int rep_ = 0; rep_ < REP_P3; ++rep_) {
    {
        pg8::StaticOrder S; S.init((unsigned)WS_ACAT, (unsigned)WS_WAB, NTOK, 1024, 1024, F.G, (int)blockIdx.x);
        EpiMerged E{ws + WS_R, ws + WS_SGB, WSR, (unsigned)WS_MG};
        pg8::gemm_phase<EpiMerged, pg8::StaticOrder, true, 0, true>(F.lds + RING_OFF, WSR, F.wave, 1024, S, E);
#if GROUPSYNC
        { pg8::Unit u0; S.next(0, u0); const int gword = CW_G3 + 64 * u0.pm; GROUP_ARRIVE(gword); GROUP_WAIT(gword, 4); }
#endif
    }
    __syncthreads(); }
#if !GROUPSYNC
    GRID_BAR();
#endif
    for (int rep_ = 0; rep_ < REP_P4; ++rep_) {
    {
        pg8::StaticOrder S; S.init((unsigned)WS_MG, (unsigned)WS_WO, NTOK, 1024, 1024, F.G, (int)blockIdx.x);
        EpiX1 E{XB, WSR, (unsigned)WS_X1B, SSQ2, X1B8};
        pg8::gemm_phase<EpiX1, pg8::StaticOrder, true, 0, false>(F.lds + RING_OFF, WSR, F.wave, 1024, S, E);
#if GROUPSYNC
        { pg8::Unit u0; S.next(0, u0); GROUP_ARRIVE(CW_G4 + 64 * u0.pm); GROUP_WAIT(CW_G4 + 64 * ((int)blockIdx.x >> 2), 4); }
#endif
    }
    __syncthreads(); }
#if !GROUPSYNC
    GRID_BAR();
#endif
    {
        LAS float* lg = (LAS float*)(F.lds + RING_OFF);
        LAS int* lcnt = (LAS int*)(F.lds + RING_OFF + 8192);
        LAS unsigned char* wrl = F.lds + RING_OFF + 16384;
        if (F.tid < 40) lcnt[F.tid] = 0;
        for (int i = F.tid; i < 32 * 128; i += NWAVES * 64) { const int n = i >> 7, c = i & 127; *(LAS v4u*)(wrl + n * 2064 + c * 16) = *(const v4u*)(WR + (size_t)n * 1024 + c * 8); }
        __syncthreads();
        const int fr = F.lane & 15, fq = F.lane >> 4;
        int e0 = 0, e1 = 0, cls = 0, rk0 = 0, rk1 = 0, rkc = 0; float w0 = 0.f, w1 = 0.f; const int tok = blockIdx.x * 64 + F.wave * 16 + F.lane;
        if (F.wave < 4) {
            const int r0 = blockIdx.x * 64 + F.wave * 16;
            f32x4 a0 = (f32x4){0.f, 0.f, 0.f, 0.f}, a1 = a0;
            const bf16* xrow = X1B + (size_t)(r0 + fr) * 1024 + 8 * fq; const LAS unsigned char* wl0 = wrl + fr * 2064 + 16 * fq; const LAS unsigned char* wl1 = wrl + (16 + fr) * 2064 + 16 * fq;
#pragma unroll
            for (int hb = 0; hb < 2; ++hb) { bf16x8 bx[16];
#pragma unroll
                for (int k = 0; k < 16; ++k) bx[k] = *(const bf16x8*)(xrow + 32 * (16 * hb + k));
#pragma unroll
                for (int k = 0; k < 16; ++k) { const int ks = 16 * hb + k; const bf16x8 wa = *(const LAS bf16x8*)(wl0 + 64 * ks), wb = *(const LAS bf16x8*)(wl1 + 64 * ks);
                    a0 = __builtin_amdgcn_mfma_f32_16x16x32_bf16(wa, bx[k], a0, 0, 0, 0); a1 = __builtin_amdgcn_mfma_f32_16x16x32_bf16(wb, bx[k], a1, 0, 0, 0); } }
            LAS float* lw = lg + F.wave * 512 + fr * 32;
#pragma unroll
            for (int r = 0; r < 4; ++r) { lw[4 * fq + r] = a0[r]; lw[16 + 4 * fq + r] = a1[r]; }
            LDS_WAIT(); asm volatile("" ::: "memory");
            if (F.lane < 16) {
                float ssq = 0.f;
#pragma unroll
                for (int i = 0; i < 16; ++i) ssq += SSQ2[(size_t)tok * 16 + i];
                const float rs = 1.f / sqrtf(ssq * (1.f / 1024.f) + EPS_);
                RSTD2[tok] = rs;
                const LAS float* l = lg + F.wave * 512 + F.lane * 32;
                float gmax = -3e38f; int gi = 0;
#pragma unroll
                for (int i = 0; i < 4; ++i) { const float v = l[i] * rs + b_rg[i]; if (v > gmax) { gmax = v; gi = i; } }
                float gs = 0.f;
#pragma unroll
                for (int i = 0; i < 4; ++i) gs += expf(l[i] * rs + b_rg[i] - gmax);
                const float gval = 1.f / gs;
                float m0 = -3e38f, m1 = -3e38f; int i0 = 0, i1 = 0;
#pragma unroll
                for (int i = 0; i < 4; ++i) { const float v = l[4 + gi * 4 + i] * rs + b_re[gi * 4 + i];
                    if (v > m0) { m1 = m0; i1 = i0; m0 = v; i0 = i; } else if (v > m1) { m1 = v; i1 = i; } }
                const float p1 = expf(m1 - m0);
                w0 = gval / (1.f + p1); w1 = gval * p1 / (1.f + p1); e0 = gi * 4 + i0; e1 = gi * 4 + i1;
                const int ilo = i0 < i1 ? i0 : i1, ihi = i0 < i1 ? i1 : i0;
                cls = gi * 6 + ((ilo == 0) ? ihi - 1 : (ilo == 1) ? ihi + 1 : 5);
                rk0 = __hip_atomic_fetch_add(lcnt + e0, 1, __ATOMIC_RELAXED, __HIP_MEMORY_SCOPE_WORKGROUP);
                rk1 = __hip_atomic_fetch_add(lcnt + e1, 1, __ATOMIC_RELAXED, __HIP_MEMORY_SCOPE_WORKGROUP);
                rkc = __hip_atomic_fetch_add(lcnt + 16 + cls, 1, __ATOMIC_RELAXED, __HIP_MEMORY_SCOPE_WORKGROUP);
            }
        }
#if DEFER_WD == 1
        else {
            static_assert(DEFER_WGU, "item numbering assumes the gate/up weights are deferred too");
            LAS float* scr = (LAS float*)(F.lds + RING_OFF + 83968 + (F.wave - 4) * 8704);
            const int lane = lane_id(), n4 = 4 * (lane & 7), k8 = lane >> 3, c8 = lane & 7;
            for (int r = (int)blockIdx.x * 4 + (F.wave - 4); r < 16 * 4 * 32 + 4 * 32; r += (int)F.G * 4) {
                const bool ple = r >= 16 * 4 * 32; const int q = ple ? r - 16 * 4 * 32 : r, e = q >> 7, kb = (q >> 5) & 3, ng = q & 31;
                const float* src = (ple ? w_ple : w_down + (size_t)e * 256 * 1024) + (size_t)(64 * kb) * 1024 + 32 * ng;
                f32x4 v[8];
#pragma unroll
                for (int i = 0; i < 8; ++i) v[i] = *(const f32x4*)(src + (size_t)(k8 + 8 * i) * 1024 + n4);
                const float sc = ple ? 1.f : 16.f;
#pragma unroll
                for (int i = 0; i < 8; ++i) { LAS float* d = scr + (k8 + 8 * i) * 33 + n4; const f32x4 w = v[i] * sc; d[0] = w[0]; d[1] = w[1]; d[2] = w[2]; d[3] = w[3]; }
                LDS_WAIT(); asm volatile("" ::: "memory");
#pragma unroll
                for (int j = 0; j < 4; ++j) { const int n = (lane >> 3) + 8 * j; const LAS float* s = scr + (8 * c8) * 33 + n;
                    if (ple) { v4u o; o.x = pk2(s[0 * 33], s[1 * 33]); o.y = pk2(s[2 * 33], s[3 * 33]); o.z = pk2(s[4 * 33], s[5 * 33]); o.w = pk2(s[6 * 33], s[7 * 33]);
                        *(v4u*)(WPLE + (size_t)(ng * 32 + n) * 256 + 64 * kb + 8 * c8) = o; }
                    else { int w0 = __builtin_amdgcn_cvt_pk_fp8_f32(s[0 * 33], s[1 * 33], 0, false); w0 = __builtin_amdgcn_cvt_pk_fp8_f32(s[2 * 33], s[3 * 33], w0, true);
                        int w1 = __builtin_amdgcn_cvt_pk_fp8_f32(s[4 * 33], s[5 * 33], 0, false); w1 = __builtin_amdgcn_cvt_pk_fp8_f32(s[6 * 33], s[7 * 33], w1, true);
                        *(unsigned long long*)((unsigned char*)WD + (size_t)e * 1024 * 256 + (size_t)(ng * 32 + n) * 256 + 64 * kb + 8 * c8) = (unsigned long long)(unsigned)w0 | ((unsigned long long)(unsigned)w1 << 32); } }
                LDS_WAIT(); asm volatile("" ::: "memory");
            }
        }
#endif
        __syncthreads();
        if (F.tid < 40) { const int c = lcnt[F.tid]; lcnt[64 + F.tid] = c ? (int)__hip_atomic_fetch_add((unsigned*)(F.ctl + CW_CNT + 64 * F.tid), (unsigned)c, __ATOMIC_RELAXED, __HIP_MEMORY_SCOPE_AGENT) : 0; }
        __syncthreads();
        if (F.wave < 4 && F.lane < 16) {
            const int p0 = lcnt[64 + e0] + rk0, p1 = lcnt[64 + e1] + rk1, pc = lcnt[64 + 16 + cls] + rkc;
            LIST[(size_t)e0 * ECAP + p0] = tok * 2; GATE[(size_t)e0 * ECAP + p0] = w0; INFO[(size_t)e0 * ECAP + p0] = (cls << 20) | (pc << 1) | (e0 < e1 ? 0 : 1);
            LIST[(size_t)e1 * ECAP + p1] = tok * 2 + 1; GATE[(size_t)e1 * ECAP + p1] = w1; INFO[(size_t)e1 * ECAP + p1] = (cls << 20) | (pc << 1) | (e1 < e0 ? 0 : 1);
            CLIST[(size_t)cls * ECAP + pc] = tok;
        }
        __syncthreads();
    }
    GRID_BAR();
    LAS int* ebase = (LAS int*)(F.lds + MOE_TAB_OFF); LAS int* cbase = ebase + 64;
    for (int rep_ = 0; rep_ < REP_P6A; ++rep_) {
    {
        LAS int* craw = ebase + 128;
        if (F.tid < 40) craw[F.tid] = (int)__hip_atomic_load((unsigned*)(F.ctl + CW_CNT + 64 * F.tid), __ATOMIC_RELAXED, __HIP_MEMORY_SCOPE_AGENT);
        __syncthreads();
        if (F.tid < 17) { int a = 0; for (int e = 0; e < 16; ++e) a += (e < F.tid) ? craw[e] : 0; ebase[F.tid] = a; }
        else if (F.tid >= 64 && F.tid < 89) { const int c0 = F.tid - 64; int a = 0; for (int c = 0; c < 24; ++c) a += (c < c0) ? craw[16 + c] : 0; cbase[c0] = a; }
        __syncthreads();
        MoeSched1 S{F.vcu, ebase, LIST, (unsigned)WS_X1B8, (unsigned)WS_WGU, (unsigned)WS_ZERO};
        EpiHid E{RSTD2, LIST, GATE, INFO, (unsigned char*)HIDP, ebase, cbase};
        pg8::gemm_phase<EpiHid, MoeSched1, true, 1, false, true>(F.lds + RING_OFF, WSR, F.wave, 1024, S, E);
    }
#if !FUSE_U
    {
        pg8::StaticOrder S; S.init((unsigned)WS_PB, (unsigned)WS_WPLE, NTOK, 1024, 256, F.G, (int)blockIdx.x);
        EpiPlain E{WSR, (unsigned)WS_U, 1024};
        pg8::gemm_phase<EpiPlain, pg8::StaticOrder, true, 0, false>(F.lds + RING_OFF, WSR, F.wave, 256, S, E);
    }
#endif
    __syncthreads(); }
    GRID_BAR();
    for (int rep_ = 0; rep_ < REP_P6B; ++rep_) {
    {
        MoeSched2 S{F.vcu, cbase, (unsigned)WS_HIDP, (unsigned)WS_WD, (unsigned)WS_ZERO};
        EpiX2 E{X1B, WSR, (unsigned)WS_X2B, SSQ3, X2B8, CLIST, cbase};
        pg8::gemm_phase<EpiX2, MoeSched2, true, 2, false, true>(F.lds + RING_OFF, WSR, F.wave, 256, S, E);
    }
    __syncthreads();
#if REPBAR
    if (rep_ + 1 < REP_P6B) GRID_BAR();
#endif
    }
    GRID_BAR();
    for (int rep_ = 0; rep_ < REP_P7; ++rep_) {
    {
        pg8::StaticOrder S; S.init((unsigned)WS_X2B8, (unsigned)WS_WPG, NTOK, 1024, 1024, F.G, (int)blockIdx.x, 1);
        LAS float* rsl = (LAS float*)(F.lds + MOE_TAB_OFF + 1024);
        { pg8::Unit u0; if (S.next(0, u0) && F.tid < 256) { const f32x4* sp = (const f32x4*)(SSQ3 + (size_t)(u0.pm * 256 + F.tid) * 16); const f32x4 s0 = sp[0], s1 = sp[1], s2 = sp[2], s3 = sp[3];
              const float ssq = ((s0[0] + s0[1]) + (s0[2] + s0[3])) + ((s1[0] + s1[1]) + (s1[2] + s1[3])) + ((s2[0] + s2[1]) + (s2[2] + s2[3])) + ((s3[0] + s3[1]) + (s3[2] + s3[3]));
              rsl[F.tid] = (1.f / 32.f) / sqrtf(ssq * (1.f / 1024.f) + EPS_); } }
        __syncthreads();
#if FUSE_U
        unsigned gst[32];
        { EpiGate E{rsl, gst};
          pg8::gemm_phase<EpiGate, pg8::StaticOrder, true, 0, false, true>(F.lds + RING_OFF, WSR, F.wave, 1024, S, E); }
        { pg8::StaticOrder SU; SU.init((unsigned)WS_PB, (unsigned)WS_WPLE, NTOK, 1024, 256, F.G, (int)blockIdx.x);
          EpiFinalU E{X2B, out, gst};
          pg8::gemm_phase<EpiFinalU, pg8::StaticOrder, true, 0, false, false>(F.lds + RING_OFF, WSR, F.wave, 256, SU, E); }
#else
        EpiFinal E{rsl, X2B, UB, out};
        pg8::gemm_phase<EpiFinal, pg8::StaticOrder, true, 0, false, true>(F.lds + RING_OFF, WSR, F.wave, 1024, S, E);
#endif
    }
    __syncthreads(); }
#ifdef TP_BAR
    if (TP_BAR == 9) { __syncthreads(); TP_SPIN_(); }
#endif
}

extern "C" void kernel_launch(void* const* d_in, const int* in_sizes, int n_in, void* d_out, int out_size, void* d_ws, size_t ws_size, hipStream_t stream) {
    static int grid = 0;
    if (grid == 0) {
        if (n_in != 22 || out_size != NTOK * DM_ || ws_size < WS_END) { fprintf(stderr, "kernel_launch: unexpected problem (n_in %d, out %d, ws %zu); nothing launched\n", n_in, out_size, ws_size); grid = -1; return; }
        int dev = 0, cus = 0, per_cu = 0;
        if (hipGetDevice(&dev) != hipSuccess || hipDeviceGetAttribute(&cus, hipDeviceAttributeMultiprocessorCount, dev) != hipSuccess) { grid = -1; return; }
        if (hipFuncSetAttribute((const void*)hybrid_fwd, hipFuncAttributeMaxDynamicSharedMemorySize, LDS_BYTES) != hipSuccess) { fprintf(stderr, "kernel_launch: hipFuncSetAttribute failed\n"); grid = -1; return; }
        if (hipOccupancyMaxActiveBlocksPerMultiprocessor(&per_cu, (const void*)hybrid_fwd, NWAVES * 64, LDS_BYTES) != hipSuccess || per_cu < 1) { fprintf(stderr, "kernel_launch: occupancy query reports %d blocks per CU\n", per_cu); (void)hipGetLastError(); grid = -1; return; }
        grid = cus;
        if (grid != 256) { fprintf(stderr, "kernel_launch: built for a 256-CU device, found %d\n", cus); grid = -1; return; }
    }
    if (grid < 0) return;
    if (hipMemsetAsync((char*)d_ws + WS_CTL, 0, CTL_ZERO_BYTES, stream) != hipSuccess) return;
#ifdef XTRA_MEMSET
    for (int i = 0; i < XTRA_MEMSET; ++i) if (hipMemsetAsync((char*)d_ws + WS_CTL, 0, CTL_ZERO_BYTES, stream) != hipSuccess) return;
#endif
    Args a{};
    for (int i = 0; i < 22; ++i) a.in[i] = (const float*)d_in[i];
    a.out = (float*)d_out; a.ws = (unsigned char*)d_ws;
    hipLaunchKernelGGL(hybrid_fwd, dim3(grid), dim3(NWAVES * 64), LDS_BYTES, stream, a);
}
```

```cpp
#ifndef CODE_PF_ENTRY
#define CODE_PF_ENTRY 0
#endif
#ifndef CODE_PF_EPI
#define CODE_PF_EPI 0
#endif
#ifndef CODE_PF
#define CODE_PF 2
#endif
#ifndef CODE_PF_SAFE
#define CODE_PF_SAFE (168u * 1024u)
#endif
#define CODE_PF_DUMP 139264
#include <hip/hip_runtime.h>
#include <hip/hip_bf16.h>
#include <cstdio>
#include <cstdint>
#include <cmath>

constexpr int DM_ = 1024, NB_ = 4, SEQ_ = 4096, NTOK = NB_ * SEQ_, NH_ = 8, HD_ = 64, AW_ = 512, CW_ = 512, PW_ = 5128;
constexpr int NE_ = 16, DE_ = 256, PLE_ = 256;
constexpr float EPS_ = 1e-6f;
constexpr int OFF_Q = 0, OFF_K = 512, OFF_V = 1024, OFF_F = 1536, OFF_CB = 1544, OFF_CC = 2056, OFF_CU = 2568, OFF_GA = 3080, OFF_GB = 4104;
constexpr float LOG2E = 1.4426950408889634f;
constexpr float QC2 = 0.125f * LOG2E;
constexpr int ECAP = NTOK;

__device__ __forceinline__ int lane_id() { int l; asm volatile("v_mbcnt_lo_u32_b32 %0, -1, 0\n\tv_mbcnt_hi_u32_b32 %0, -1, %0" : "=v"(l)); return l; }

namespace pg8 {
#define PG8_LAS __attribute__((address_space(3)))
typedef unsigned short bf16_t;
typedef short bf16x8 __attribute__((ext_vector_type(8)));
typedef float f32x4 __attribute__((ext_vector_type(4)));
typedef unsigned u32x4 __attribute__((ext_vector_type(4)));
typedef unsigned u32x2 __attribute__((ext_vector_type(2)));
constexpr int BM = 256, BK = 64, HALF = 128, HTB = HALF * BK * 2, STAGE_BYTES = 8 * HTB, NXCD = 8, WGM = 8;

__host__ __device__ __forceinline__ int lds_byte(int r, int c) { const int st = (r >> 4) * 2 + (c >> 5), rr = r & 15, cc = c & 31, ob = rr * 64 + cc * 2; return st * 1024 + (ob ^ (((ob >> 9) & 1) << 5)); }
__host__ __device__ __forceinline__ void stage_rc(int b, int& R, int& C) { const int st = b / 1024, sb = b % 1024, swz = sb ^ (((sb >> 9) & 1) << 5); R = (st >> 1) * 16 + swz / 64; C = (st & 1) * 32 + (swz % 64) / 2; }
__host__ __device__ __forceinline__ int g8(int row) { const int h = (row >> 1) & 7; return h ^ (((h >> 1) & 1) << 2); }
__host__ __device__ __forceinline__ int perm32(int rho) { const int n = rho >> 4, i = rho & 15; return 8 * (i >> 2) + 4 * n + (i & 3); }

struct Unit { int pm, pn; unsigned a; unsigned b; const int* rows; int nvalid; int e; int pos0; int chain; int rlo, rhi; unsigned zoff; };

struct StaticOrder {
    int nM, nN, nwg, G, c; unsigned A, Bt, tileA, tileB;
    __device__ void init(unsigned A_, unsigned Bt_, int M, int N, int K_, int G_, int c_, int esz = 2) { A = A_; Bt = Bt_; tileA = tileB = (unsigned)(BM * K_ * esz); nM = M / BM; nN = N / BM; nwg = nM * nN; G = G_; c = c_; }
    __device__ bool next(int i, Unit& u) const {
        const long L = (long)i * G + c; if (L >= nwg) return false;
        int wgid = (int)L; { const int q = nwg / NXCD, r = nwg % NXCD, xcd = wgid % NXCD, off = wgid / NXCD; wgid = (xcd < r ? xcd * (q + 1) : r * (q + 1) + (xcd - r) * q) + off; }
        const int nig = WGM * nN, gid = wgid / nig, fm = gid * WGM, gsz = (nM - fm) < WGM ? (nM - fm) : WGM;
        u.pm = fm + ((wgid % nig) % gsz); u.pn = (wgid % nig) / gsz;
        u.a = A + (unsigned)u.pm * tileA; u.b = Bt + (unsigned)u.pn * tileB; u.rows = nullptr; u.nvalid = BM; u.e = 0; u.pos0 = 0; u.chain = 0; u.rlo = 0; u.rhi = BM; u.zoff = 0u; return true;
    }
};

typedef int i32x8 __attribute__((ext_vector_type(8)));
__device__ __forceinline__ i32x8 cat8(bf16x8 a, bf16x8 b) { typedef int i32x4 __attribute__((ext_vector_type(4))); const i32x4 x = __builtin_bit_cast(i32x4, a), y = __builtin_bit_cast(i32x4, b); return (i32x8){x[0], x[1], x[2], x[3], y[0], y[1], y[2], y[3]}; }
__device__ __forceinline__ unsigned cvt_pk_bf16(float lo, float hi) { unsigned r; asm volatile("v_cvt_pk_bf16_f32 %0, %1, %2" : "=v"(r) : "v"(lo), "v"(hi)); return r; }
__device__ __forceinline__ float bf_lo(unsigned w) { return __uint_as_float(w << 16); }
__device__ __forceinline__ float bf_hi(unsigned w) { return __uint_as_float(w & 0xffff0000u); }

template <class Epi, class Sched, bool ALIGN_EPI, int GATHER, bool MIDK, bool FP8 = false>
__device__ __forceinline__ void gemm_phase(PG8_LAS unsigned char* lds, const __amdgpu_buffer_rsrc_t RS, const int wave, const int K, const Sched& S, const Epi& E) {
    int lane = lane_id(); asm volatile("" : "+v"(lane));
    const int wid = wave, tid = wave * 64 + lane, wr = wid >> 2, wc = wid & 3, fr = lane & 15, fq = lane >> 4;
    int nt = FP8 ? K / (2 * BK) : K / BK; asm volatile("" : "+s"(nt));
    const int PBY = FP8 ? K : 2 * K;
    unsigned voffB[2], vbase[2]; int RA[2];
#pragma unroll
    for (int i = 0; i < 2; ++i) { int R, C; if constexpr (FP8) { const int b = tid * 16 + i * 8192; R = b >> 7; C = 8 * (((b >> 4) & 7) ^ g8(R)); } else stage_rc(tid * 16 + i * 8192, R, C);
        const int Rb = (R & ~31) + perm32(R & 31);
        RA[i] = R; vbase[i] = (unsigned)C * 2u; voffB[i] = (unsigned)(Rb * PBY + C * 2); }
    const unsigned kstep = (unsigned)(BK * 2);
    const unsigned hstepu = (unsigned)(HALF * PBY);
    const unsigned hstep = hstepu;
    const unsigned ldsw = (unsigned)wid * 1024u;
    const int aoff = FP8 ? (wr * 64 + fr) * 128 + (((2 * fq) ^ g8(wr * 64 + fr)) << 4) : lds_byte(wr * 64 + fr, fq * 8), boff = FP8 ? (wc * 32 + fr) * 128 + (((2 * fq) ^ g8(wc * 32 + fr)) << 4) : lds_byte(wc * 32 + fr, fq * 8);
    int boffh = boff + 4 * HTB; asm volatile("" : "+v"(boffh));
    const int aoff2 = aoff ^ 16; int boff2h = (boff ^ 16) + 4 * HTB; asm volatile("" : "+v"(boff2h));
#define PG8_SA(b, h) (((b) * 2 + (h)) * HTB)
#define PG8_SB(b, h) ((4 + (b) * 2 + (h)) * HTB)
#define PG8_STAGE(bufoff, gbase, voff) do { _Pragma("unroll") for (int _i = 0; _i < 2; ++_i) \
        __builtin_amdgcn_raw_ptr_buffer_load_lds(RS, (PG8_LAS void*)(lds + (bufoff) + ldsw + _i * 8192), 16, (int)(voff)[_i], (int)(gbase), 0, 0); } while (0)
#define PG8_LDA(dst, b, h) do { _Pragma("unroll") for (int m = 0; m < 4; ++m) _Pragma("unroll") for (int k = 0; k < 2; ++k) dst[m][k] = *(const PG8_LAS bf16x8*)(lds + PG8_SA(b, h) + (FP8 ? (k ? aoff2 : aoff) : aoff + k * 1024) + m * 2048); } while (0)
#define PG8_LDB(dst, b, h) do { _Pragma("unroll") for (int n = 0; n < 2; ++n) _Pragma("unroll") for (int k = 0; k < 2; ++k) dst[n][k] = *(const PG8_LAS bf16x8*)(lds + (PG8_SB(b, h) - 4 * HTB) + (FP8 ? (k ? boff2h : boffh) : boffh + k * 1024) + n * 2048); } while (0)
#define PG8_MMA(ai, bj, At, Bt) do { __builtin_amdgcn_s_setprio(1); _Pragma("unroll") for (int m = 0; m < 4; ++m) _Pragma("unroll") for (int n = 0; n < 2; ++n) { \
        if constexpr (FP8) acc[ai][bj][m][n] = __builtin_amdgcn_mfma_scale_f32_16x16x128_f8f6f4(cat8(Bt[n][0], Bt[n][1]), cat8(At[m][0], At[m][1]), acc[ai][bj][m][n], 0, 0, 0, 0x7f7f7f7f, 0, 0x7f7f7f7f); \
        else { _Pragma("unroll") for (int k = 0; k < 2; ++k) acc[ai][bj][m][n] = __builtin_amdgcn_mfma_f32_16x16x32_bf16(Bt[n][k], At[m][k], acc[ai][bj][m][n], 0, 0, 0); } } __builtin_amdgcn_s_setprio(0); } while (0)
#define A1S(p) (GATHER ? (p) : (p) + hstepu)
#define A1V(v1, v0) (GATHER ? (v1) : (v0))
#define PG8_WAIT_V(n) asm volatile("s_waitcnt vmcnt(" #n ")" ::: "memory")
#define PG8_WAIT_L(n) asm volatile("s_waitcnt lgkmcnt(" #n ")" ::: "memory")
#define PG8_BAR __builtin_amdgcn_s_barrier()
#define PG8_SCHED __builtin_amdgcn_sched_barrier(0)
#define PG8_AOFF(u, dst) do { _Pragma("unroll") for (int _h = 0; _h < 2; ++_h) _Pragma("unroll") for (int _i = 0; _i < 2; ++_i) { \
        if constexpr (GATHER != 0) { const int _r = _h * HALF + RA[_i]; const bool _in = (_r >= (u).rlo) && (_r < (u).rhi); \
            if constexpr (GATHER == 1) { const int _row = _in ? ((u).rows[_r] >> 1) : 0; dst[_h][_i] = (_in ? (unsigned)_row * (unsigned)PBY : (u).zoff) + vbase[_i]; } \
            else dst[_h][_i] = (_in ? (unsigned)_r * (unsigned)PBY : (u).zoff) + vbase[_i]; } \
        else dst[_h][_i] = (unsigned)RA[_i] * (unsigned)PBY + vbase[_i]; }     } while (0)
    Unit cur, nxt; int ui = 0;
    if (!S.next(0, cur)) return;
    f32x4 acc[2][2][4][2];
#pragma unroll
    for (int a = 0; a < 2; ++a)
#pragma unroll
        for (int b = 0; b < 2; ++b)
#pragma unroll
            for (int m = 0; m < 4; ++m)
#pragma unroll
                for (int n = 0; n < 2; ++n) acc[a][b][m][n] = (f32x4){0.f, 0.f, 0.f, 0.f};
    bf16x8 At[4][2], B0[2][2], B1[2][2];
    unsigned va[2][2], na[2][2];
    PG8_AOFF(cur, va);
    unsigned cA = cur.a, cB = cur.b;
    PG8_STAGE(PG8_SB(0, 0), cB, voffB); PG8_STAGE(PG8_SB(0, 1), cB + hstep, voffB); PG8_STAGE(PG8_SA(0, 0), cA, va[0]); PG8_STAGE(PG8_SA(0, 1), A1S(cA), A1V(va[1], va[0]));
    if (wr == 1) PG8_BAR;
    PG8_WAIT_V(2); PG8_BAR;
    PG8_STAGE(PG8_SB(1, 0), cB + kstep, voffB); PG8_STAGE(PG8_SA(1, 0), cA + kstep, va[0]); PG8_STAGE(PG8_SB(1, 1), cB + hstep + kstep, voffB);
    PG8_WAIT_V(6); PG8_BAR;
    for (;;) {
        const bool has_next = S.next(ui + 1, nxt);
        const unsigned nA = has_next ? nxt.a : cA, nB = has_next ? nxt.b : cB;
        if constexpr (GATHER) { if (has_next) { PG8_AOFF(nxt, na); } else {
#pragma unroll
            for (int h = 0; h < 2; ++h)
#pragma unroll
                for (int i = 0; i < 2; ++i) na[h][i] = va[h][i]; } }
        for (int t = 0; t < nt; t += 2) {
            const bool last = (t == nt - 2);
#if CODE_PF
            if (CODE_PF_EPI && last && ui == 0 && wave == 1) {
                unsigned long long pc_; asm volatile("s_getpc_b64 %0" : "=s"(pc_)); const int l_ = lane_id();
                const unsigned long long a_ = (pc_ & ~255ULL) + (unsigned long long)((blockIdx.x >> 3) & 31u) * 512u + (unsigned)(l_ & 31) * 16u;
                if (l_ < 32) __builtin_amdgcn_global_load_lds((const __attribute__((address_space(1))) void*)a_, (PG8_LAS void*)(lds + CODE_PF_DUMP), 16, 0, 0);
            }
#endif
            if constexpr (MIDK) { if (t == nt / 2) { int t2 = lane_id(); asm volatile("" : "+v"(t2)); E.mid(acc, cur, wr, wc, t2 & 15, (t2 >> 4) & 3); } }
            const unsigned a1 = cA + (unsigned)(t + 1) * kstep;
            const unsigned a2 = last ? nA : cA + (unsigned)(t + 2) * kstep, b2 = last ? nB : cB + (unsigned)(t + 2) * kstep;
            const unsigned a3 = a2 + kstep, b3 = b2 + kstep;
            unsigned x0[2], x1[2];
#pragma unroll
            for (int i = 0; i < 2; ++i) { if constexpr (GATHER) { x0[i] = last ? na[0][i] : va[0][i]; x1[i] = last ? na[1][i] : va[1][i]; } else { x0[i] = va[0][i]; x1[i] = va[1][i]; } }
            PG8_LDB(B0, 0, 0); PG8_LDB(B1, 0, 1); PG8_SCHED; PG8_LDA(At, 0, 0); PG8_STAGE(PG8_SA(1, 1), A1S(a1), A1V(va[1], va[0]));
            PG8_WAIT_V(8); PG8_WAIT_L(0); PG8_BAR; PG8_MMA(0, 0, At, B0); PG8_MMA(0, 1, At, B1); PG8_BAR; PG8_SCHED;
            PG8_LDA(At, 0, 1); PG8_STAGE(PG8_SB(0, 0), b2, voffB); PG8_STAGE(PG8_SB(0, 1), b2 + hstep, voffB); PG8_STAGE(PG8_SA(0, 0), a2, x0);
            PG8_WAIT_V(8); PG8_WAIT_L(0); PG8_BAR; PG8_MMA(1, 0, At, B0); PG8_MMA(1, 1, At, B1); PG8_BAR; PG8_SCHED;
            PG8_LDB(B0, 1, 0); PG8_LDB(B1, 1, 1); PG8_SCHED; PG8_LDA(At, 1, 0); PG8_STAGE(PG8_SA(0, 1), A1S(a2), A1V(x1, x0));
            PG8_WAIT_V(8); PG8_WAIT_L(0); PG8_BAR; PG8_MMA(0, 0, At, B0); PG8_MMA(0, 1, At, B1); PG8_BAR; PG8_SCHED;
            PG8_LDA(At, 1, 1); PG8_STAGE(PG8_SB(1, 0), b3, voffB); PG8_STAGE(PG8_SB(1, 1), b3 + hstep, voffB); PG8_STAGE(PG8_SA(1, 0), a3, x0);
            PG8_WAIT_V(8); PG8_WAIT_L(0); PG8_BAR; PG8_MMA(1, 0, At, B0); PG8_MMA(1, 1, At, B1); PG8_BAR; PG8_SCHED;
        }
        if (!cur.chain) {
            if constexpr (ALIGN_EPI) { if (wr == 0) PG8_BAR; }
            { int t2 = lane_id(); asm volatile("" : "+v"(t2)); E(acc, cur, wr, wc, t2 & 15, (t2 >> 4) & 3); }
        }
        if (!has_next) break;
        if (!cur.chain) {
#pragma unroll
            for (int a = 0; a < 2; ++a)
#pragma unroll
                for (int b = 0; b < 2; ++b)
#pragma unroll
                    for (int m = 0; m < 4; ++m)
#pragma unroll
                        for (int n = 0; n < 2; ++n) acc[a][b][m][n] = (f32x4){0.f, 0.f, 0.f, 0.f};
        }
        const bool was_chain = cur.chain != 0;
        cur = nxt; cA = nA; cB = nB; ++ui;
        if constexpr (GATHER) {
#pragma unroll
            for (int h = 0; h < 2; ++h)
#pragma unroll
                for (int i = 0; i < 2; ++i) va[h][i] = na[h][i]; }
        if constexpr (ALIGN_EPI) { if (!was_chain) { if (wr == 1) PG8_BAR; } }
    }
    PG8_WAIT_V(0);
    if constexpr (!ALIGN_EPI) { if (wr == 0) PG8_BAR; }
    PG8_BAR;
#undef PG8_SA
#undef PG8_SB
#undef PG8_STAGE
#undef PG8_LDA
#undef PG8_LDB
#undef PG8_MMA
#undef PG8_WAIT_V
#undef PG8_WAIT_L
#undef PG8_BAR
#undef PG8_SCHED
#undef PG8_AOFF
#undef A1S
#undef A1V
}
}

namespace attn_body {
using bf16=__hip_bfloat16;
using bf16x8=__attribute__((ext_vector_type(8)))short;
using s16x4=__attribute__((ext_vector_type(4)))short;
using f32x16=__attribute__((ext_vector_type(16)))float;
using f32x4v=__attribute__((ext_vector_type(4)))float;
using u32x4=__attribute__((ext_vector_type(4)))unsigned;
constexpr int SEQ=SEQ_,D=64,DM=NH_*D;
constexpr int OPITCH=1024;
constexpr int NW=8,QBLK=32,QB=QBLK*NW,KVBLK=64,NQB=SEQ/QB;
__device__ __forceinline__ int crow(int r,int hi){return (r&3)+8*(r>>2)+4*hi;}
#define SBAR() __builtin_amdgcn_sched_barrier(0)
__device__ __forceinline__ void cmask(f32x16&p0,f32x16&p1,int jb,int qrel,int hi){
  const float NEG=-INFINITY; int kb=64*jb+4*hi;
  #pragma unroll
  for(int r=0;r<16;++r){int kv=kb+(r&3)+8*(r>>2); if(kv>qrel)p0[r]=NEG; if(kv+32>qrel)p1[r]=NEG;}
}
constexpr int NSLOT=3, SLOTB=8192;
constexpr int LDS_K=0, LDS_V=NSLOT*SLOTB, LDS_WS=2*NSLOT*SLOTB, LDS_OST=LDS_WS+NW*64*4, LDS_CT=LDS_OST+NW*4096, LDS_WT=LDS_CT+SEQ*4, LDS_BYTES=LDS_WT+NW*256;
__device__ __forceinline__ void glds16(const void*gsrc,unsigned lds_dst){unsigned keep;
  asm volatile("s_mov_b32 %0, m0\n\ts_mov_b32 m0, %2\n\ts_nop 0\n\tglobal_load_lds_dwordx4 %1, off\n\ts_mov_b32 m0, %0":"=&s"(keep):"v"(gsrc),"s"(lds_dst):"memory");}
typedef float f32x2_t __attribute__((ext_vector_type(2))); typedef __bf16 bf16x2_t __attribute__((ext_vector_type(2)));
__device__ __forceinline__ unsigned cvtpk_s(float lo,float hi){f32x2_t v={lo,hi};bf16x2_t b=__builtin_convertvector(v,bf16x2_t);return __builtin_bit_cast(unsigned,b);}
#define WAIT_BAR(N) asm volatile("s_waitcnt vmcnt(" #N ") lgkmcnt(0)\n\ts_barrier":::"memory")
typedef __attribute__((address_space(3))) const char* lds_cptr;
typedef short v4i16_t __attribute__((ext_vector_type(4)));
#define LDS3 __attribute__((address_space(3)))
__device__ __forceinline__ void kload8(bf16x8*kf,lds_cptr kp){
  kf[0]=*(const LDS3 bf16x8*)(kp);      kf[1]=*(const LDS3 bf16x8*)(kp+512);
  kf[2]=*(const LDS3 bf16x8*)(kp+2048); kf[3]=*(const LDS3 bf16x8*)(kp+2560);
  kf[4]=*(const LDS3 bf16x8*)(kp+4096); kf[5]=*(const LDS3 bf16x8*)(kp+4608);
  kf[6]=*(const LDS3 bf16x8*)(kp+6144); kf[7]=*(const LDS3 bf16x8*)(kp+6656);
}
__device__ __forceinline__ void kload2(bf16x8*kf,lds_cptr kp,int j){ kf[2*j]=*(const LDS3 bf16x8*)(kp+j*2048); kf[2*j+1]=*(const LDS3 bf16x8*)(kp+j*2048+512); }
__device__ __forceinline__ s16x4 vtr(lds_cptr p){ return __builtin_bit_cast(s16x4,__builtin_amdgcn_ds_read_tr16_b64_v4i16((LDS3 v4i16_t*)p)); }
__device__ __forceinline__ void bias_load(f32x16&p0,f32x16&p1,lds_cptr wt,int hi){
  #pragma unroll
  for(int g=0;g<4;++g){
    const f32x4v a=*(const LDS3 f32x4v*)(wt+(2*g+hi)*16); const f32x4v b=*(const LDS3 f32x4v*)(wt+(8+2*g+hi)*16);
    p0[4*g]=a[0];p0[4*g+1]=a[1];p0[4*g+2]=a[2];p0[4*g+3]=a[3]; p1[4*g]=b[0];p1[4*g+1]=b[1];p1[4*g+2]=b[2];p1[4*g+3]=b[3];}
}
__device__ __forceinline__ void pv(f32x16*o,int vb,bf16x8 pa0,bf16x8 pa1,bf16x8 pa2,bf16x8 pa3){
  #pragma unroll
  for(int d0=0;d0<2;++d0){s16x4 lo[4],hi[4];
    #pragma unroll
    for(int ks=0;ks<4;++ks){
      asm volatile("ds_read_b64_tr_b16 %0,%1 offset:%c2":"=&v"(lo[ks]):"v"(vb),"i"(d0*4096+ks*1024):"memory");
      asm volatile("ds_read_b64_tr_b16 %0,%1 offset:%c2":"=&v"(hi[ks]):"v"(vb),"i"(d0*4096+ks*1024+512):"memory");}
    asm volatile("s_waitcnt lgkmcnt(0)":::"memory");SBAR();
    #define PK(k) (bf16x8){lo[k][0],lo[k][1],lo[k][2],lo[k][3],hi[k][0],hi[k][1],hi[k][2],hi[k][3]}
    o[d0]=__builtin_amdgcn_mfma_f32_32x32x16_bf16(pa0,PK(0),o[d0],0,0,0);
    o[d0]=__builtin_amdgcn_mfma_f32_32x32x16_bf16(pa1,PK(1),o[d0],0,0,0);
    o[d0]=__builtin_amdgcn_mfma_f32_32x32x16_bf16(pa2,PK(2),o[d0],0,0,0);
    o[d0]=__builtin_amdgcn_mfma_f32_32x32x16_bf16(pa3,PK(3),o[d0],0,0,0);
    #undef PK
  }
}
#define ATTN_STORE16(p,v) __builtin_amdgcn_raw_buffer_store_b128((v), wsr, (unsigned)((const char*)(p) - wsbase), 0, 0)
__device__ __forceinline__ void attn_unit(int b,int h,int qb,int t0,float m2,const bf16*Q,const bf16*__restrict__ K,const bf16*__restrict__ V,bf16*O,char*shm,const __amdgpu_buffer_rsrc_t wsr,const char*wsbase,const int wave){
  int lane=lane_id(); asm volatile("":"+v"(lane)); const int r32=lane&31,hi=lane>>5; const int wid=wave;
  const long rowbase=(long)b*SEQ; const int q0=qb*QB;
  const bf16*Qw=Q+(rowbase+q0+wid*QBLK)*DM+h*D;
  const bf16*Kh=K+rowbase*DM+h*D,*Vh=V+rowbase*DM+h*D;
  const unsigned lds0=(unsigned)(uintptr_t)shm;
  float*wsf=(float*)(shm+LDS_WS)+wid*64;
  const bf16*ksrc=Kh+(long)lane*DM+wid*8;
  const bf16*vsrc=Vh+(long)(16*(wid&3)+(lane>>2))*DM+(wid>>2)*32+(lane&3)*8;
  const unsigned kdst=lds0+LDS_K+wid*1024, vdst=lds0+LDS_V+wid*1024;
  #define DMA_K(t,slot) glds16(ksrc+(long)(t)*KVBLK*DM,(unsigned)__builtin_amdgcn_readfirstlane(kdst+(slot)))
  #define DMA_V(t,slot) glds16(vsrc+(long)(t)*KVBLK*DM,(unsigned)__builtin_amdgcn_readfirstlane(vdst+(slot)))
  const int vb0=(int)(lds0+LDS_V)+((lane>>4)&1)*32+(lane&3)*8+(4*hi+((lane&15)>>2))*64;
  bf16x8 kf[8];
  const lds_cptr shm3=(lds_cptr)shm; const lds_cptr kp0=shm3+LDS_K+hi*1024+r32*16; const lds_cptr vp0=shm3+LDS_V+((lane>>4)&1)*32+(lane&3)*8+(4*hi+((lane&15)>>2))*64;
  const lds_cptr ct=shm3+LDS_CT; const lds_cptr wt=shm3+LDS_WT+wid*256;
  LDS3 float* wtw=(LDS3 float*)(shm3+LDS_WT+wid*256)+lane;
  const int NT=(q0+QB)/KVBLK;
  const float kw=-(*(const LDS3 float*)(ct+(q0+wid*QBLK+QBLK-1)*4))-m2;
  #define WTAB(t) do{ const float cv_=*(const LDS3 float*)(ct+((t)*KVBLK+lane)*4); *wtw=cv_+kw; }while(0)
  DMA_K(t0,0);DMA_V(t0,0);DMA_K(t0+1,SLOTB);
  bf16x8 qr[4];
  #pragma unroll
  for(int d0=0;d0<4;++d0)qr[d0]=*reinterpret_cast<const bf16x8*>(&Qw[(long)r32*DM+d0*16+hi*8]);
  float l_reg=0.f;f32x16 o[2];o[0]=f32x16{};o[1]=f32x16{};
  const int qrel=wid*QBLK+r32;
  #define CMASK(P0,P1,t) do{int jb_=(t)-(NT-4); if(jb_>=0)cmask(P0,P1,jb_,qrel,hi);}while(0)
  f32x16 pA0,pA1,pB0,pB1;
  int sl_prev=0,sl_cur=0,sl_next=SLOTB;
  #define ROT() do{sl_prev=sl_cur;sl_cur=sl_next;sl_next=(sl_next==(NSLOT-1)*SLOTB)?0:sl_next+SLOTB;}while(0)
  DMA_K(t0+2,2*SLOTB);
  WTAB(t0);
  WAIT_BAR(3);
  bias_load(pA0,pA1,wt,hi);
  { const char*kb=shm+LDS_K+hi*1024+r32*16;
    #pragma unroll
    for(int d0=0;d0<4;++d0){
      const bf16x8 b0=*reinterpret_cast<const bf16x8*>(kb+d0*2048);
      const bf16x8 b1=*reinterpret_cast<const bf16x8*>(kb+d0*2048+512);
      pA0=__builtin_amdgcn_mfma_f32_32x32x16_bf16(b0,qr[d0],pA0,0,0,0);pA1=__builtin_amdgcn_mfma_f32_32x32x16_bf16(b1,qr[d0],pA1,0,0,0);} }
  CMASK(pA0,pA1,t0);
  _Pragma("unroll") for(int r=0;r<16;++r){pA0[r]=__builtin_amdgcn_exp2f(pA0[r]);pA1[r]=__builtin_amdgcn_exp2f(pA1[r]);}
  WTAB(t0+1);
  WAIT_BAR(0);
  DMA_K(t0+3,0);DMA_V(t0+1,SLOTB);
  ROT();
  kload8(kf,kp0+sl_cur);
  bias_load(pB0,pB1,wt,hi);
  WAIT_BAR(2);
  s16x4 vlo[8],vhi[8]; u32x4 pw0,pw1,pw2,pw3;
  #define PKW(P,B) cvtpk_s(P[B],P[B+1])
  #define PAF(k) __builtin_bit_cast(bf16x8,pw##k)
  #define VFR(i) (bf16x8){vlo[i][0],vlo[i][1],vlo[i][2],vlo[i][3],vhi[i][0],vhi[i][1],vhi[i][2],vhi[i][3]}
  #define PIN(x) asm volatile("":"+v"(x))
  #define GAPA(MF,A0,A1,A2,A3,W0,W1,PW) do{ MF; sacc+=A0; sacc+=A1; sacc+=A2; sacc+=A3; PIN(sacc); W0; W1; PIN(PW); SBAR(); }while(0)
  #define EX(v) __builtin_amdgcn_exp2f(v)
  #define GAPB(MF,X,B) do{ MF; X[B]=EX(X[B]); X[B+1]=EX(X[B+1]); X[B+2]=EX(X[B+2]); X[B+3]=EX(X[B+3]); PIN(X); SBAR(); }while(0)
  #define VRD(i) do{ vlo[i]=vtr(vp_+(((i)>>2)*4096+((i)&3)*1024)); vhi[i]=vtr(vp_+(((i)>>2)*4096+((i)&3)*1024+512)); }while(0)
  #define KRD(G,j) do{ if(G){ kload2(kf,kp0+sl_next,j); SBAR(); } }while(0)
  #define STEP(C0,C1,P0,P1,t,GK,GV,GL) do{ SBAR(); \
    const lds_cptr vp_=vp0+sl_prev; \
    VRD(0); SBAR(); float sacc=(P0[0]+P0[1]); \
    GAPA(C0=__builtin_amdgcn_mfma_f32_32x32x16_bf16(kf[0],qr[0],C0,0,0,0), P0[2],P0[3],P0[4],P0[5],     pw0[0]=PKW(P0,0), pw0[1]=PKW(P0,2), pw0); \
    VRD(4); SBAR(); GAPA(C1=__builtin_amdgcn_mfma_f32_32x32x16_bf16(kf[1],qr[0],C1,0,0,0), P0[6],P0[7],P0[8],P0[9],     pw0[2]=PKW(P0,4), pw0[3]=PKW(P0,6), pw0); \
    VRD(1); SBAR(); GAPA(C0=__builtin_amdgcn_mfma_f32_32x32x16_bf16(kf[2],qr[1],C0,0,0,0),   P0[10],P0[11],P0[12],P0[13], pw1[0]=PKW(P0,8), pw1[1]=PKW(P0,10), pw1); \
    VRD(5); SBAR(); GAPA(C1=__builtin_amdgcn_mfma_f32_32x32x16_bf16(kf[3],qr[1],C1,0,0,0),   P0[14],P0[15],P1[0],P1[1],   pw1[2]=PKW(P0,12),pw1[3]=PKW(P0,14), pw1); \
    VRD(2); SBAR(); GAPA(C0=__builtin_amdgcn_mfma_f32_32x32x16_bf16(kf[4],qr[2],C0,0,0,0),   P1[2],P1[3],P1[4],P1[5],     pw2[0]=PKW(P1,0), pw2[1]=PKW(P1,2), pw2); \
    VRD(6); SBAR(); GAPA(C1=__builtin_amdgcn_mfma_f32_32x32x16_bf16(kf[5],qr[2],C1,0,0,0),   P1[6],P1[7],P1[8],P1[9],     pw2[2]=PKW(P1,4), pw2[3]=PKW(P1,6), pw2); \
    VRD(3); SBAR(); GAPA(C0=__builtin_amdgcn_mfma_f32_32x32x16_bf16(kf[6],qr[3],C0,0,0,0),   P1[10],P1[11],P1[12],P1[13], pw3[0]=PKW(P1,8), pw3[1]=PKW(P1,10), pw3); \
    VRD(7); SBAR(); GAPA(C1=__builtin_amdgcn_mfma_f32_32x32x16_bf16(kf[7],qr[3],C1,0,0,0),   P1[14],P1[15],0.f,0.f,       pw3[2]=PKW(P1,12),pw3[3]=PKW(P1,14), pw3); \
    l_reg+=sacc; \
    if(GK){DMA_K((t)+3,sl_cur);} if(GV){DMA_V((t)+1,sl_next);} \
    CMASK(C0,C1,t); \
    if(GL){ WTAB((t)+1); } \
    SBAR(); \
    GAPB(o[0]=__builtin_amdgcn_mfma_f32_32x32x16_bf16(PAF(0),VFR(0),o[0],0,0,0), C0,0); \
    GAPB(o[1]=__builtin_amdgcn_mfma_f32_32x32x16_bf16(PAF(0),VFR(4),o[1],0,0,0), C0,4); \
    KRD(GL,0); GAPB(o[0]=__builtin_amdgcn_mfma_f32_32x32x16_bf16(PAF(1),VFR(1),o[0],0,0,0), C0,8); \
    KRD(GL,1); GAPB(o[1]=__builtin_amdgcn_mfma_f32_32x32x16_bf16(PAF(1),VFR(5),o[1],0,0,0), C0,12); \
    KRD(GL,2); GAPB(o[0]=__builtin_amdgcn_mfma_f32_32x32x16_bf16(PAF(2),VFR(2),o[0],0,0,0), C1,0); \
    KRD(GL,3); GAPB(o[1]=__builtin_amdgcn_mfma_f32_32x32x16_bf16(PAF(2),VFR(6),o[1],0,0,0), C1,4); \
    GAPB(o[0]=__builtin_amdgcn_mfma_f32_32x32x16_bf16(PAF(3),VFR(3),o[0],0,0,0), C1,8); \
    GAPB(o[1]=__builtin_amdgcn_mfma_f32_32x32x16_bf16(PAF(3),VFR(7),o[1],0,0,0), C1,12); \
    if(GL){ bias_load(P0,P1,wt,hi); } \
    }while(0)
  int t=t0+1;
  #undef CMASK
  #define CMASK(P0,P1,t) do{}while(0)
  for(;t+5<NT;t+=2){
    STEP(pB0,pB1,pA0,pA1,t,true,true,true);     WAIT_BAR(2); ROT();
    STEP(pA0,pA1,pB0,pB1,t+1,true,true,true);   WAIT_BAR(2); ROT();
  }
  #undef CMASK
  #define CMASK(P0,P1,t) do{int jb_=(t)-(NT-4); if(jb_>=0)cmask(P0,P1,jb_,qrel,hi);}while(0)
  #define ENDW(tt) do{ if((tt)+3<NT){WAIT_BAR(2);} else if((tt)+2<NT){WAIT_BAR(1);} else {WAIT_BAR(0);} }while(0)
  for(;t+1<NT;t+=2){
    STEP(pB0,pB1,pA0,pA1,t,(t+3<NT),(t+1<NT),(t+1<NT));       ENDW(t);   ROT();
    STEP(pA0,pA1,pB0,pB1,t+1,(t+4<NT),(t+2<NT),(t+2<NT));     ENDW(t+1); ROT();
  }
  STEP(pB0,pB1,pA0,pA1,NT-1,false,false,false);
  { float sacc=pB0[0]+pB0[1]; _Pragma("unroll") for(int r=2;r<16;++r)sacc+=pB0[r]; _Pragma("unroll") for(int r=0;r<16;++r)sacc+=pB1[r]; l_reg+=sacc;
    pw0=(u32x4){PKW(pB0,0),PKW(pB0,2),PKW(pB0,4),PKW(pB0,6)};pw1=(u32x4){PKW(pB0,8),PKW(pB0,10),PKW(pB0,12),PKW(pB0,14)};pw2=(u32x4){PKW(pB1,0),PKW(pB1,2),PKW(pB1,4),PKW(pB1,6)};pw3=(u32x4){PKW(pB1,8),PKW(pB1,10),PKW(pB1,12),PKW(pB1,14)};
    SBAR(); pv(o,vb0+sl_cur,PAF(0),PAF(1),PAF(2),PAF(3)); }
  #undef PKW
  #undef PAF
  #undef VFR
  #undef PIN
  #undef GAPA
  #undef GAPB
  #undef EX
  #undef VRD
  #undef KRD
  #undef STEP
  #undef ENDW
  {auto rr=__builtin_amdgcn_permlane32_swap(__float_as_uint(l_reg),__float_as_uint(l_reg),false,false);l_reg=__uint_as_float(rr[0])+__uint_as_float(rr[1]);}
  if(hi==0)wsf[32+r32]=l_reg;asm volatile("s_waitcnt lgkmcnt(0)":::"memory");
  float rli[16];
  #pragma unroll
  for(int r=0;r<16;++r)rli[r]=__builtin_amdgcn_rcpf(wsf[32+crow(r,hi)]);
  bf16*Ow=O+(rowbase+q0+wid*QBLK)*OPITCH+h*D;
  { bf16*stg=(bf16*)(shm+LDS_OST)+wid*2048;
    #pragma unroll
    for(int r=0;r<16;++r){const int orow=crow(r,hi);
      #pragma unroll
      for(int d0=0;d0<2;++d0)stg[orow*64+d0*32+r32]=__float2bfloat16(o[d0][r]*rli[r]);}
    asm volatile("s_waitcnt lgkmcnt(0)":::"memory");
    #pragma unroll
    for(int i=0;i<4;++i){const int row=i*8+(lane>>3),ch=lane&7; const u32x4 v=*(const u32x4*)(stg+row*64+ch*8); ATTN_STORE16(Ow+(long)row*OPITCH+ch*8,v);} }
  asm volatile("s_waitcnt lgkmcnt(0)\n\ts_barrier":::"memory");
  #undef DMA_K
  #undef DMA_V
  #undef CMASK
  #undef ROT
  #undef WTAB
}
constexpr int ATTN_LDS_BYTES=LDS_BYTES;
#undef SBAR
#undef WAIT_BAR
}

constexpr size_t MiB = 1u << 20;
constexpr size_t WS_CTL = 0, CTL_ZERO_BYTES = 256 * 1024;
constexpr size_t WS_WIN = 2 * MiB, WS_WAB = 12 * MiB, WS_WO = 14 * MiB, WS_WGU = 16 * MiB, WS_WD = 32 * MiB, WS_WPG = 40 * MiB, WS_WPLE = 42 * MiB, WS_WR = 43 * MiB;
constexpr size_t WS_RSTD1 = 44 * MiB, WS_LF = 44 * MiB + 256 * 1024, WS_C = 45 * MiB, WS_SSQ2 = 46 * MiB, WS_RSTD2 = 47 * MiB, WS_RSTD3 = 47 * MiB + 256 * 1024;
constexpr size_t WS_LIST = 48 * MiB, WS_GATE = 49 * MiB;
constexpr size_t WS_XB = 50 * MiB;
constexpr size_t WS_ACAT = 194 * MiB, WS_HIDP = 50 * MiB;
constexpr size_t HPLANE = (size_t)96 * 256 * 256;
constexpr size_t WS_Q = 82 * MiB, WS_K = 98 * MiB, WS_V = 114 * MiB;
constexpr size_t WS_MG = 82 * MiB, WS_X2B = 82 * MiB;
constexpr size_t WS_X1B = 114 * MiB;
constexpr size_t WS_CCU = 130 * MiB, WS_CB = 146 * MiB;
constexpr size_t WS_U = 146 * MiB;
constexpr size_t WS_R = 162 * MiB, WS_SGB = 178 * MiB;
constexpr size_t WS_PB = 230 * MiB;
constexpr size_t WS_INFO = 238 * MiB;
constexpr size_t WS_CLIST = 239 * MiB;
constexpr size_t WS_SSQ3 = 241 * MiB;
constexpr size_t WS_X2B8 = 194 * MiB, WS_X1B8 = 210 * MiB;
constexpr size_t WS_WIN8 = 226 * MiB;
constexpr size_t WS_XB8 = 238 * MiB;
constexpr size_t WS_ZERO = 254 * MiB;
constexpr size_t WS_END = 254 * MiB + 4096;
static_assert(2 * HPLANE * 2 <= 32 * MiB, "hidden planes fit their region");
constexpr int CW_BAR = 4096;
constexpr int CW_QHEAD = 12288;
constexpr int CW_CNT = 16384;
constexpr int CW_G3 = 20480, CW_G4 = 24576;
static_assert((CW_CNT + 64 * 40) <= CW_G3 && (CW_G4 + 64 * 64) * 4 <= (int)CTL_ZERO_BYTES, "CTL words inside the memset region");
constexpr int RING_OFF = 0, RING_BYTES = 131072;
constexpr int LDSCTL_OFF = RING_BYTES, MISC_OFF = LDSCTL_OFF + 320;
constexpr int MOE_TAB_OFF = LDSCTL_OFF + 1024;
constexpr int LDS_BYTES = 147456;
static_assert(MISC_OFF + 128 <= MOE_TAB_OFF && MOE_TAB_OFF + 1024 + 1024 <= LDS_BYTES, "LDS map");
constexpr int NWAVES = 8;

#define GAS __attribute__((address_space(1)))
#define LAS __attribute__((address_space(3)))
typedef unsigned short bf16;
typedef unsigned v4u __attribute__((ext_vector_type(4)));
typedef float f32x4 __attribute__((ext_vector_type(4)));
typedef short bf16x8 __attribute__((ext_vector_type(8)));
typedef GAS unsigned gu32;
typedef GAS unsigned long long gu64;
#define RLX_AGENT __ATOMIC_RELAXED, __HIP_MEMORY_SCOPE_AGENT
#define LDS_WAIT() asm volatile("s_waitcnt lgkmcnt(0)" ::: "memory")
#define VM_WAIT() asm volatile("s_waitcnt vmcnt(0)" ::: "memory")
__device__ __forceinline__ unsigned long long rt() { return __builtin_amdgcn_s_memrealtime(); }
__device__ __forceinline__ unsigned f2bf(float f) { unsigned u = __builtin_bit_cast(unsigned, f); return (u + 0x7fffu + ((u >> 16) & 1u)) >> 16; }
__device__ __forceinline__ unsigned pk2(float lo, float hi) { return f2bf(lo) | (f2bf(hi) << 16); }

#define XB_TMO      128
#define XB_XCNT(j)  (256  + 64 * (j))
#define XB_XSUB(j)  (1280 + 64 * (j))
#define XB_XGEN(j)  (2304 + 64 * (j))
#define XB_TOP      3328
#define XB_TOPGEN   3392
#define XCD_BAR_WORDS 3456
#define XB_SPIN_CAP (1u << 18)

__device__ __forceinline__ unsigned xb_ld(unsigned* p)              { return __hip_atomic_load(p, __ATOMIC_RELAXED, __HIP_MEMORY_SCOPE_AGENT); }
__device__ __forceinline__ unsigned xb_add(unsigned* p, unsigned v) { return __hip_atomic_fetch_add(p, v, __ATOMIC_RELAXED, __HIP_MEMORY_SCOPE_AGENT); }
__device__ __forceinline__ unsigned xb_xcc_id() { return (unsigned)__builtin_amdgcn_s_getreg((3 << 11) | 20) & 0xFu; }
#define XB_SPIN(cond, bar) do { unsigned _sp = 0; while (cond) { __builtin_amdgcn_s_sleep(1); \
    if ((++_sp & 255u) == 0u) { if (xb_ld(&(bar)[XB_TMO])) break; if (_sp > XB_SPIN_CAP) { atomicAdd(&(bar)[XB_TMO], 1u); break; } } } } while (0)

struct XcdBarrier {
    unsigned* bar; unsigned x;
    volatile LAS unsigned* st;
};

__device__ __forceinline__ XcdBarrier xcd_barrier_post(unsigned* bar, volatile LAS unsigned* st, const int tid_) {
    XcdBarrier b; b.bar = bar; b.x = xb_xcc_id(); b.st = st;
    if (tid_ == 0) (void)xb_add(&bar[XB_XCNT(b.x)], 1u);
#if CODE_PF
    if (tid_ == 0) { unsigned long long pc_; asm volatile("s_getpc_b64 %0" : "=s"(pc_)); pc_ &= ~4095ULL; st[2] = (unsigned)pc_; st[3] = (unsigned)(pc_ >> 32); }
#endif
    return b;
}
__device__ __forceinline__ void xcd_barrier_complete(unsigned* bar, unsigned x, unsigned& nloc, unsigned& nx) {
    const unsigned G = gridDim.x * gridDim.y * gridDim.z;
    unsigned sum, cnt, mine, sp = 0u;
    for (;;) {
        sum = 0u; cnt = 0u; mine = 0u;
#pragma unroll
        for (unsigned j = 0; j < 16; ++j) { const unsigned c = xb_ld(&bar[XB_XCNT(j)]); sum += c; cnt += (c > 0u) ? 1u : 0u; mine = (j == x) ? c : mine; }
        if (sum == G) break;
        __builtin_amdgcn_s_sleep(1);
        if ((++sp & 255u) == 0u) { if (xb_ld(&bar[XB_TMO])) break; if (sp > XB_SPIN_CAP) { atomicAdd(&bar[XB_TMO], 1u); break; } }
    }
    nloc = mine > 0u ? mine : 1u; nx = cnt > 0u ? cnt : 1u;
}

__device__ __forceinline__ void xcd_barrier(const XcdBarrier& b, const int tid_) {
    asm volatile("s_waitcnt vmcnt(0)" ::: "memory");
    __syncthreads();
#if CODE_PF
    if (tid_ >= 64 && tid_ < 64 + 64 * CODE_PF) {
        unsigned long long pc_; asm volatile("s_getpc_b64 %0" : "=s"(pc_));
        const unsigned long long lo_ = (pc_ & ~255ULL) + (unsigned long long)((blockIdx.x >> 3) & 31u) * (1024u * CODE_PF) + (unsigned)(tid_ - 64) * 16u;
        const unsigned long long end_ = ((unsigned long long)b.st[3] << 32 | b.st[2]) + CODE_PF_SAFE;
        if (lo_ + 16u <= end_) { v4u t_; asm volatile("global_load_dwordx4 %0, %1, off\n\ts_waitcnt vmcnt(0)" : "=&v"(t_) : "v"(lo_) : "memory"); }
    }
#endif
    if (tid_ == 0) {
        unsigned* bar = b.bar;
        __builtin_amdgcn_s_waitcnt(0);
        unsigned nloc = b.st[0], nx = b.st[1];
        if (nloc == 0u) { xcd_barrier_complete(bar, b.x, nloc, nx); b.st[0] = nloc; b.st[1] = nx; }
        const unsigned old = xb_add(&bar[XB_XSUB(b.x)], 1u);
        const unsigned gen = old / nloc;
        if (old + 1u == (gen + 1u) * nloc) {
            __builtin_amdgcn_fence(__ATOMIC_RELEASE, "agent");
            asm volatile("s_waitcnt vmcnt(0)" ::: "memory");
            const unsigned og = xb_add(&bar[XB_TOP], 1u);
            const unsigned tg = og / nx;
            if (og + 1u == (tg + 1u) * nx) xb_add(&bar[XB_TOPGEN], 1u);
            else XB_SPIN(xb_ld(&bar[XB_TOPGEN]) == tg, bar);
            __builtin_amdgcn_fence(__ATOMIC_ACQUIRE, "agent");
            xb_add(&bar[XB_XGEN(b.x)], 1u);
            asm volatile("s_waitcnt vmcnt(0)" ::: "memory");
        } else {
#if EARLY_WB
            asm volatile("buffer_wbl2 sc1" ::: "memory");
#endif
            XB_SPIN(xb_ld(&bar[XB_XGEN(b.x)]) == gen, bar);
            __builtin_amdgcn_fence(__ATOMIC_ACQUIRE, "agent");
            asm volatile("s_waitcnt vmcnt(0)" ::: "memory");
        }
    }
    __syncthreads();
}


struct Args { const float* in[22]; float* out; unsigned char* ws; };
struct Frame {
    LAS unsigned char* lds; volatile LAS unsigned* MISC; gu32* ctl;
    int tid, lane, wave, vcu, G;
};
__device__ __forceinline__ float wave_sum(float v) {
#pragma unroll
    for (int o = 1; o < 64; o <<= 1) v += __shfl_xor(v, o);
    return v;
}
__device__ __forceinline__ void conv_item(const float* W, int ld, int scol, const float* g, bf16* WT, int Kd, int drow, int kd0, LAS float* scr, int lane) {
#pragma unroll 8
    for (int i = 0; i < 32; ++i) { const int kk = 2 * i + (lane >> 5); const float gv = g ? g[kk] : 1.f; scr[kk * 33 + (lane & 31)] = W[(size_t)kk * ld + scol + (lane & 31)] * gv; }
    LDS_WAIT(); asm volatile("" ::: "memory");
    const int c = lane & 7;
#pragma unroll
    for (int j = 0; j < 4; ++j) { const int n = (lane >> 3) + 8 * j; const LAS float* s = scr + (8 * c) * 33 + n;
        v4u o; o.x = pk2(s[0 * 33], s[1 * 33]); o.y = pk2(s[2 * 33], s[3 * 33]); o.z = pk2(s[4 * 33], s[5 * 33]); o.w = pk2(s[6 * 33], s[7 * 33]);
        *(GAS v4u*)(WT + (size_t)(drow + n) * Kd + kd0 + 8 * c) = o; }
    LDS_WAIT(); asm volatile("" ::: "memory");
}
__device__ __forceinline__ int win_scol(int ng) {
    const int pn = ng >> 3, gidx = ng & 7, bj = gidx >> 2, wc = gidx & 3;
    if (pn < 2) return OFF_Q + (4 * pn + wc) * 64 + 32 * bj;
    if (pn < 4) return OFF_K + (4 * (pn - 2) + wc) * 64 + 32 * bj;
    if (pn < 6) return OFF_V + (4 * (pn - 4) + wc) * 64 + 32 * bj;
    if (pn < 10) return (bj ? OFF_CU : OFF_CC) + (pn - 6) * 128 + 32 * wc;
    if (pn < 12) return OFF_CB + (pn - 10) * 256 + 32 * gidx;
    return (bj ? OFF_GB : OFF_GA) + (pn - 12) * 128 + 32 * wc;
}

using pg8::u32x4; using pg8::Unit; using pg8::cvt_pk_bf16; using pg8::bf_lo; using pg8::bf_hi;
typedef __amdgpu_buffer_rsrc_t wsrc_t;
#ifndef WT_AUX
#define WT_AUX 0
#endif
#define WTS(R, byteoff, val) __builtin_amdgcn_raw_buffer_store_b128((val), (R), (unsigned)(byteoff), 0, WT_AUX)
#define EPI_ARGS const f32x4 (&acc)[2][2][4][2], const Unit& u, int wr, int wc, int fr, int fq
#define EPI_OPAQUE() asm volatile("" : "+v"(fr), "+v"(fq))
__device__ __forceinline__ u32x4 pack8(const f32x4 a, const f32x4 b) { u32x4 w; w.x = cvt_pk_bf16(a[0], a[1]); w.y = cvt_pk_bf16(a[2], a[3]); w.z = cvt_pk_bf16(b[0], b[1]); w.w = cvt_pk_bf16(b[2], b[3]); return w; }
__device__ __forceinline__ void unpack8(const u32x4 w, f32x4& a, f32x4& b) { a = (f32x4){bf_lo(w.x), bf_hi(w.x), bf_lo(w.y), bf_hi(w.y)}; b = (f32x4){bf_lo(w.z), bf_hi(w.z), bf_lo(w.w), bf_hi(w.w)}; }
__device__ __forceinline__ float xor16_add(float v) { return v + __int_as_float(__builtin_amdgcn_ds_swizzle(__float_as_int(v), 0x401F)); }
__device__ __forceinline__ float xor32_add(float v) { auto r = __builtin_amdgcn_permlane32_swap(__float_as_uint(v), __float_as_uint(v), false, false); return __uint_as_float(r[0]) + __uint_as_float(r[1]); }
__device__ __forceinline__ pg8::u32x2 pack8_fp8(const f32x4 a, const f32x4 b) { int w0 = __builtin_amdgcn_cvt_pk_fp8_f32(a[0], a[1], 0, false); w0 = __builtin_amdgcn_cvt_pk_fp8_f32(a[2], a[3], w0, true);
    int w1 = __builtin_amdgcn_cvt_pk_fp8_f32(b[0], b[1], 0, false); w1 = __builtin_amdgcn_cvt_pk_fp8_f32(b[2], b[3], w1, true); return (pg8::u32x2){(unsigned)w0, (unsigned)w1}; }
__device__ __forceinline__ unsigned pack4_u8(const f32x4 v) { int w = __builtin_amdgcn_cvt_pk_u8_f32(v[0], 0, 0); w = __builtin_amdgcn_cvt_pk_u8_f32(v[1], 1, w); w = __builtin_amdgcn_cvt_pk_u8_f32(v[2], 2, w); return (unsigned)__builtin_amdgcn_cvt_pk_u8_f32(v[3], 3, w); }
__device__ __forceinline__ f32x4 unpack4_u8(unsigned w) { return (f32x4){(float)(w & 0xffu), (float)((w >> 8) & 0xffu), (float)((w >> 16) & 0xffu), (float)(w >> 24)}; }
__device__ __forceinline__ float sigm_c(float v) { v = fminf(fmaxf(v, -60.f), 60.f); return __builtin_amdgcn_rcpf(1.f + __builtin_amdgcn_exp2f(-v * LOG2E)); }

#define GROUP_ROW(g) (((g) >> 2) * 128 + wr * 64 + ((g) & 3) * 16 + fr)
struct EpiP1 {
    const float* rstd1; const float* gq; const float* gk; wsrc_t W; unsigned Q, Kb, V, CCU, CB; unsigned char* R8; unsigned char* SGB8;
    float wscale;
    __device__ __forceinline__ void operator()(EPI_ARGS) const { EPI_OPAQUE();
        const int pn = u.pn, row0 = u.pm * 256;
        float rsv[8];
#pragma unroll
        for (int g = 0; g < 8; ++g) rsv[g] = rstd1[row0 + GROUP_ROW(g)] * wscale;
        if (pn < 4) {
            const bool isk = pn >= 2; const float* gg = isk ? gk : gq; const int head = 4 * (pn & 1) + wc; const float sc = isk ? 1.f : QC2;
            const unsigned base = (isk ? Kb : Q) + (unsigned)(head * 64 + 8 * fq) * 2u;
#pragma unroll
            for (int g = 0; g < 8; ++g) { const int ai = g >> 2, m = g & 3; const int row = row0 + GROUP_ROW(g); const float rs = rsv[g];
                f32x4 g4[2][2];
#pragma unroll
                for (int bj = 0; bj < 2; ++bj)
#pragma unroll
                    for (int n = 0; n < 2; ++n) g4[bj][n] = *(const f32x4*)(gg + 32 * bj + 8 * fq + 4 * n) * sc;
                f32x4 v[2][2]; float ss = 0.f;
#pragma unroll
                for (int bj = 0; bj < 2; ++bj)
#pragma unroll
                    for (int n = 0; n < 2; ++n) { v[bj][n] = acc[ai][bj][m][n] * rs; ss += (v[bj][n][0] * v[bj][n][0] + v[bj][n][1] * v[bj][n][1]) + (v[bj][n][2] * v[bj][n][2] + v[bj][n][3] * v[bj][n][3]); }
                ss = xor16_add(ss); ss = xor32_add(ss);
                const float r = __builtin_amdgcn_rsqf(ss * (1.f / 64.f) + EPS_);
#pragma unroll
                for (int bj = 0; bj < 2; ++bj) WTS(W, base + (unsigned)(row * 512 + 32 * bj) * 2u, pack8(v[bj][0] * r * g4[bj][0], v[bj][1] * r * g4[bj][1])); }
        } else if (pn < 6) {
            const unsigned base = V + (unsigned)((4 * (pn - 4) + wc) * 64 + 8 * fq) * 2u;
#pragma unroll
            for (int g = 0; g < 8; ++g) { const int ai = g >> 2, m = g & 3; const int row = row0 + GROUP_ROW(g); const float rs = rsv[g];
#pragma unroll
                for (int bj = 0; bj < 2; ++bj) WTS(W, base + (unsigned)(row * 512 + 32 * bj) * 2u, pack8(acc[ai][bj][m][0] * rs, acc[ai][bj][m][1] * rs)); }
        } else if (pn < 10) {
            const unsigned base = CCU + (unsigned)((pn - 6) * 128 + 32 * wc + 8 * fq) * 2u;
#pragma unroll
            for (int g = 0; g < 8; ++g) { const int ai = g >> 2, m = g & 3; const int row = row0 + GROUP_ROW(g); const float r2 = rsv[g] * rsv[g];
                WTS(W, base + (unsigned)(row * 512) * 2u, pack8(acc[ai][0][m][0] * acc[ai][1][m][0] * r2, acc[ai][0][m][1] * acc[ai][1][m][1] * r2)); }
        } else if (pn < 12) {
            const unsigned base = CB + (unsigned)((pn - 10) * 256 + 32 * wc + 8 * fq) * 2u;
#pragma unroll
            for (int g = 0; g < 8; ++g) { const int ai = g >> 2, m = g & 3; const int row = row0 + GROUP_ROW(g); const float rs = rsv[g];
#pragma unroll
                for (int bj = 0; bj < 2; ++bj) WTS(W, base + (unsigned)(row * 512 + 128 * bj) * 2u, pack8(acc[ai][bj][m][0] * rs, acc[ai][bj][m][1] * rs)); }
        } else {
            const int ch = (pn - 12) * 128 + 32 * wc + 8 * fq;
#pragma unroll
            for (int g = 0; g < 8; ++g) { const int ai = g >> 2, m = g & 3; const int row = row0 + GROUP_ROW(g); const float nrs = -rsv[g] * LOG2E;
                f32x4 sa[2], sg[2];
#pragma unroll
                for (int n = 0; n < 2; ++n)
#pragma unroll
                    for (int j = 0; j < 4; ++j) {
                        const float ea = __builtin_amdgcn_exp2f(acc[ai][0][m][n][j] * nrs), eb = __builtin_amdgcn_exp2f(acc[ai][1][m][n][j] * nrs);
                        sa[n][j] = __builtin_amdgcn_rcpf(__builtin_fmaf(ea, 1.f / 255.f, 1.f / 255.f)); sg[n][j] = fmaxf(__builtin_amdgcn_rcpf(__builtin_fmaf(eb, 1.f / 255.f, 1.f / 255.f)), 1.f); }
                *(pg8::u32x2*)(R8 + (size_t)row * 1024 + ch) = (pg8::u32x2){pack4_u8(sa[0]), pack4_u8(sa[1])}; *(pg8::u32x2*)(SGB8 + (size_t)row * 1024 + ch) = (pg8::u32x2){pack4_u8(sg[0]), pack4_u8(sg[1])}; }
        }
    }
};
struct EpiMerged {
    const unsigned char* R8; const unsigned char* SGB8; wsrc_t W; unsigned MG;
    __device__ __forceinline__ void mid(f32x4 (&acc)[2][2][4][2], const Unit& u, int wr, int wc, int fr, int fq) const { EPI_OPAQUE();
        const size_t base = (size_t)u.pm * 256 * 1024 + u.pn * 256 + wc * 32 + 8 * fq;
#pragma unroll
        for (int h = 0; h < 2; ++h) { pg8::u32x2 wa[4][2], wb[4][2];
#pragma unroll
            for (int k = 0; k < 4; ++k)
#pragma unroll
                for (int bj = 0; bj < 2; ++bj) { const size_t off = base + (size_t)GROUP_ROW(4 * h + k) * 1024 + 128 * bj; wa[k][bj] = *(const pg8::u32x2*)(R8 + off); wb[k][bj] = *(const pg8::u32x2*)(SGB8 + off); }
#pragma unroll
            for (int k = 0; k < 4; ++k)
#pragma unroll
                for (int bj = 0; bj < 2; ++bj)
#pragma unroll
                    for (int n = 0; n < 2; ++n) { const f32x4 a = unpack4_u8(n ? wa[k][bj].y : wa[k][bj].x), b = unpack4_u8(n ? wb[k][bj].y : wb[k][bj].x);
#pragma unroll
                        for (int j = 0; j < 4; ++j) acc[h][bj][k][n][j] *= a[j] * __builtin_amdgcn_rcpf(b[j]); }
            asm volatile("" ::: "memory"); }
    }
    __device__ __forceinline__ void operator()(EPI_ARGS) const { EPI_OPAQUE();
        const size_t base = (size_t)u.pm * 256 * 1024 + u.pn * 256 + wc * 32 + 8 * fq;
        pg8::u32x2 wb[8][2];
#pragma unroll
        for (int g = 0; g < 8; ++g)
#pragma unroll
            for (int bj = 0; bj < 2; ++bj) wb[g][bj] = *(const pg8::u32x2*)(SGB8 + base + (size_t)GROUP_ROW(g) * 1024 + 128 * bj);
#pragma unroll
        for (int g = 0; g < 8; ++g)
#pragma unroll
            for (int bj = 0; bj < 2; ++bj) { const f32x4 a = unpack4_u8(wb[g][bj].x) * (1.f / 255.f), b = unpack4_u8(wb[g][bj].y) * (1.f / 255.f);
                WTS(W, MG + (unsigned)(base + (size_t)GROUP_ROW(g) * 1024 + 128 * bj) * 2u, pack8(acc[g >> 2][bj][g & 3][0] * a, acc[g >> 2][bj][g & 3][1] * b)); }
    }
};
struct EpiX1 {
    const bf16* x; wsrc_t W; unsigned X1B; float* SSQ; unsigned char* X1B8;
    struct In { u32x4 v[2][2]; };
    __device__ __forceinline__ void load(In& I, size_t base, int p, int wr, int fr) const {
#pragma unroll
        for (int q = 0; q < 2; ++q)
#pragma unroll
            for (int bj = 0; bj < 2; ++bj) I.v[q][bj] = *(const u32x4*)(x + base + (size_t)GROUP_ROW(2 * p + q) * 1024 + 128 * bj);
    }
    __device__ __forceinline__ void apply(const In& I, const f32x4 (&acc)[2][2][4][2], const Unit& u, size_t base, int p, int wr, int wc, int fr, int fq) const {
#pragma unroll
        for (int q = 0; q < 2; ++q) { const int g = 2 * p + q, ai = g >> 2, m = g & 3; const int trow = GROUP_ROW(g); float ss = 0.f;
#pragma unroll
            for (int bj = 0; bj < 2; ++bj) { f32x4 a, b; unpack8(I.v[q][bj], a, b); a += acc[ai][bj][m][0]; b += acc[ai][bj][m][1];
                const u32x4 w = pack8(a, b); WTS(W, X1B + (unsigned)(base + (size_t)trow * 1024 + 128 * bj) * 2u, w); f32x4 ra, rb; unpack8(w, ra, rb);
                *(pg8::u32x2*)(X1B8 + base + (size_t)trow * 1024 + 128 * bj) = pack8_fp8(ra, rb);
                ss += (ra[0] * ra[0] + ra[1] * ra[1]) + (ra[2] * ra[2] + ra[3] * ra[3]) + (rb[0] * rb[0] + rb[1] * rb[1]) + (rb[2] * rb[2] + rb[3] * rb[3]); }
            ss = xor16_add(ss); ss = xor32_add(ss);
            if (fq == 0) SSQ[(size_t)(u.pm * 256 + trow) * 16 + u.pn * 4 + wc] = ss; }
    }
    __device__ __forceinline__ void operator()(EPI_ARGS) const { EPI_OPAQUE();
        const size_t base = (size_t)u.pm * 256 * 1024 + u.pn * 256 + wc * 32 + 8 * fq;
        In A, B;
        load(A, base, 0, wr, fr); load(B, base, 1, wr, fr);
        apply(A, acc, u, base, 0, wr, wc, fr, fq); load(A, base, 2, wr, fr);
        apply(B, acc, u, base, 1, wr, wc, fr, fq); load(B, base, 3, wr, fr);
        apply(A, acc, u, base, 2, wr, wc, fr, fq);
        apply(B, acc, u, base, 3, wr, wc, fr, fq);
    }
};
struct EpiPlain { wsrc_t W; unsigned O; int ldc;
    __device__ __forceinline__ void operator()(EPI_ARGS) const { EPI_OPAQUE();
        const int row0 = u.pm * 256 + wr * 64 + fr, col0 = u.pn * 256 + wc * 32 + 8 * fq;
#pragma unroll
        for (int ai = 0; ai < 2; ++ai)
#pragma unroll
            for (int m = 0; m < 4; ++m) { const size_t off = (size_t)(row0 + ai * 128 + m * 16) * ldc + col0;
#pragma unroll
                for (int bj = 0; bj < 2; ++bj) WTS(W, O + (unsigned)(off + 128 * bj) * 2u, pack8(acc[ai][bj][m][0], acc[ai][bj][m][1])); }
    }
};
struct EpiHid { const float* RSTD2; const int* LIST; const float* GATE; const int* INFO; unsigned char* HIDP8; const LAS int* ebase; const LAS int* cbase;
    __device__ __forceinline__ void operator()(EPI_ARGS) const { EPI_OPAQUE();
#pragma unroll
        for (int hh = 0; hh < 2; ++hh) {
        int ent[4], inf[4]; float gw[4], rs[4];
#pragma unroll
        for (int k = 0; k < 4; ++k) { const int gpos = u.pm * 256 + GROUP_ROW(4 * hh + k); int e = 0;
#pragma unroll
            for (int j = 1; j < 16; ++j) e += (ebase[j] <= gpos) ? 1 : 0;
            const size_t li = (size_t)e * ECAP + (gpos - ebase[e]); ent[k] = LIST[li]; inf[k] = INFO[li]; gw[k] = GATE[li]; }
#pragma unroll
        for (int k = 0; k < 4; ++k) rs[k] = RSTD2[ent[k] >> 1] * (1.f / 32.f);
        float nrs[4], ic[4];
#pragma unroll
        for (int k = 0; k < 4; ++k) { nrs[k] = -rs[k] * LOG2E; ic[k] = __builtin_amdgcn_rcpf(rs[k] * rs[k] * (gw[k] * 16.f)); }
#pragma unroll
        for (int k = 0; k < 4; ++k) { const int ai = hh, m = k;
            f32x4 h[2];
#pragma unroll
            for (int n = 0; n < 2; ++n)
#pragma unroll
                for (int j = 0; j < 4; ++j) { const float e = fminf(__builtin_amdgcn_exp2f(acc[ai][0][m][n][j] * nrs[k]), 1e30f);
                    h[n][j] = (acc[ai][0][m][n][j] * acc[ai][1][m][n][j]) * __builtin_amdgcn_rcpf(__builtin_fmaf(e, ic[k], ic[k])); }
            const int cls = inf[k] >> 20, cpos = (inf[k] >> 1) & 0x7ffff; const size_t drow = (size_t)cbase[cls] + cpos;
            *(pg8::u32x2*)(HIDP8 + (size_t)(inf[k] & 1) * HPLANE + drow * 256 + u.pn * 128 + 32 * wc + 8 * fq) = pack8_fp8(h[0], h[1]); }
        asm volatile("" ::: "memory"); }
    }
};
struct EpiX2 { const bf16* X1B; wsrc_t W; unsigned X2B; float* SSQ; unsigned char* X2B8; const int* CLIST; const LAS int* cbase;
    struct In { u32x4 w[2][2]; };
    __device__ __forceinline__ void load(In& I, const int (&tok)[8], size_t cb, int p) const {
#pragma unroll
        for (int q = 0; q < 2; ++q)
#pragma unroll
            for (int bj = 0; bj < 2; ++bj) I.w[q][bj] = *(const u32x4*)(X1B + (size_t)tok[2 * p + q] * 1024 + cb + 128 * bj);
    }
    __device__ __forceinline__ void apply(const In& I, const f32x4 (&acc)[2][2][4][2], const Unit& u, const int (&tok)[8], size_t cb, int p, int wc, int fq) const {
#pragma unroll
        for (int q = 0; q < 2; ++q) { const int g = 2 * p + q, ai = g >> 2, m = g & 3; float ss = 0.f;
#pragma unroll
            for (int bj = 0; bj < 2; ++bj) { f32x4 a, b; unpack8(I.w[q][bj], a, b); a += acc[ai][bj][m][0] * (1.f / 256.f); b += acc[ai][bj][m][1] * (1.f / 256.f);
                const u32x4 w = pack8(a, b); f32x4 ra, rb; unpack8(w, ra, rb);
                WTS(W, X2B + (unsigned)((size_t)tok[g] * 1024 + cb + 128 * bj) * 2u, w); *(pg8::u32x2*)(X2B8 + (size_t)tok[g] * 1024 + cb + 128 * bj) = pack8_fp8(ra, rb);
                ss += (ra[0] * ra[0] + ra[1] * ra[1]) + (ra[2] * ra[2] + ra[3] * ra[3]) + (rb[0] * rb[0] + rb[1] * rb[1]) + (rb[2] * rb[2] + rb[3] * rb[3]); }
            ss = xor16_add(ss); ss = xor32_add(ss);
            if (fq == 0) SSQ[(size_t)tok[g] * 16 + u.pn * 4 + wc] = ss; }
    }
    __device__ __forceinline__ void operator()(EPI_ARGS) const { EPI_OPAQUE();
        int tok[8];
#pragma unroll
        for (int g = 0; g < 8; ++g) { const int gpos = u.pm * 256 + GROUP_ROW(g); int c = 0;
#pragma unroll
            for (int j = 1; j < 24; ++j) c += (cbase[j] <= gpos) ? 1 : 0;
            tok[g] = CLIST[(size_t)c * ECAP + (gpos - cbase[c])]; }
        const size_t cb = (size_t)u.pn * 256 + 32 * wc + 8 * fq;
        In A, B;
        load(A, tok, cb, 0); load(B, tok, cb, 1);
        apply(A, acc, u, tok, cb, 0, wc, fq); load(A, tok, cb, 2);
        apply(B, acc, u, tok, cb, 1, wc, fq); load(B, tok, cb, 3);
        apply(A, acc, u, tok, cb, 2, wc, fq);
        apply(B, acc, u, tok, cb, 3, wc, fq);
    }
};
struct EpiFinal { const LAS float* rsl; const bf16* X2B; const bf16* U; float* OUT;
    struct In { u32x4 xw[2][2], uw[2][2]; };
    __device__ __forceinline__ void load(In& I, size_t base, int p, int wr, int fr) const {
#pragma unroll
        for (int q = 0; q < 2; ++q)
#pragma unroll
            for (int bj = 0; bj < 2; ++bj) { const size_t off = base + (size_t)GROUP_ROW(2 * p + q) * 1024 + 128 * bj; I.xw[q][bj] = *(const u32x4*)(X2B + off); I.uw[q][bj] = *(const u32x4*)(U + off); }
    }
    __device__ __forceinline__ void apply(const In& I, const f32x4 (&acc)[2][2][4][2], size_t base, int p, int wr, int fr) const {
#pragma unroll
        for (int q = 0; q < 2; ++q) { const int g = 2 * p + q, ai = g >> 2, m = g & 3; const int trow = GROUP_ROW(g); const float rs = rsl[trow];
#pragma unroll
            for (int bj = 0; bj < 2; ++bj) { f32x4 ua, ub, a, b; unpack8(I.uw[q][bj], ua, ub); unpack8(I.xw[q][bj], a, b);
#pragma unroll
                for (int j = 0; j < 4; ++j) { a[j] += sigm_c(acc[ai][bj][m][0][j] * rs) * ua[j]; b[j] += sigm_c(acc[ai][bj][m][1][j] * rs) * ub[j]; }
                float* o = OUT + base + (size_t)trow * 1024 + 128 * bj;
#if OUT_NT
                __builtin_nontemporal_store(a, (f32x4*)o); __builtin_nontemporal_store(b, (f32x4*)(o + 4)); } }
#else
                *(f32x4*)o = a; *(f32x4*)(o + 4) = b; } }
#endif
    }
    __device__ __forceinline__ void operator()(EPI_ARGS) const { EPI_OPAQUE();
        const size_t base = (size_t)u.pm * 256 * 1024 + u.pn * 256 + wc * 32 + 8 * fq;
        In A, B;
        load(A, base, 0, wr, fr); load(B, base, 1, wr, fr);
        apply(A, acc, base, 0, wr, fr); load(A, base, 2, wr, fr);
        apply(B, acc, base, 1, wr, fr); load(B, base, 3, wr, fr);
        apply(A, acc, base, 2, wr, fr);
        apply(B, acc, base, 3, wr, fr);
    }
};
struct EpiGate { const LAS float* rsl; unsigned (&st)[32];
    __device__ __forceinline__ void operator()(EPI_ARGS) const { EPI_OPAQUE();
#pragma unroll
        for (int g = 0; g < 8; ++g) { const float nrs = -rsl[GROUP_ROW(g)] * LOG2E;
#pragma unroll
            for (int bj = 0; bj < 2; ++bj)
#pragma unroll
                for (int n = 0; n < 2; ++n) { f32x4 s;
#pragma unroll
                    for (int j = 0; j < 4; ++j) s[j] = __builtin_amdgcn_rcpf(__builtin_fmaf(__builtin_amdgcn_exp2f(acc[g >> 2][bj][g & 3][n][j] * nrs), 1.f / 255.f, 1.f / 255.f));
                    st[(g * 2 + bj) * 2 + n] = pack4_u8(s); } }
    }
};
struct EpiFinalU { const bf16* X2B; float* OUT; const unsigned (&st)[32];
    struct In { u32x4 xw[2][2]; };
    __device__ __forceinline__ void load(In& I, size_t base, int p, int wr, int fr) const {
#pragma unroll
        for (int q = 0; q < 2; ++q)
#pragma unroll
            for (int bj = 0; bj < 2; ++bj) I.xw[q][bj] = *(const u32x4*)(X2B + base + (size_t)GROUP_ROW(2 * p + q) * 1024 + 128 * bj);
    }
    __device__ __forceinline__ void apply(const In& I, const f32x4 (&acc)[2][2][4][2], size_t base, int p, int wr, int fr) const {
#pragma unroll
        for (int q = 0; q < 2; ++q) { const int g = 2 * p + q, ai = g >> 2, m = g & 3; const int trow = GROUP_ROW(g);
#pragma unroll
            for (int bj = 0; bj < 2; ++bj) { f32x4 a, b; unpack8(I.xw[q][bj], a, b);
                unsigned s0 = st[(g * 2 + bj) * 2 + 0], s1 = st[(g * 2 + bj) * 2 + 1]; asm volatile("" : "+v"(s0), "+v"(s1));
                const f32x4 ga = unpack4_u8(s0) * (1.f / 255.f), gb = unpack4_u8(s1) * (1.f / 255.f);
                a += ga * acc[ai][bj][m][0]; b += gb * acc[ai][bj][m][1];
                float* o = OUT + base + (size_t)trow * 1024 + 128 * bj; *(f32x4*)o = a; *(f32x4*)(o + 4) = b; } }
    }
    __device__ __forceinline__ void operator()(EPI_ARGS) const { EPI_OPAQUE();
        const size_t base = (size_t)u.pm * 256 * 1024 + u.pn * 256 + wc * 32 + 8 * fq;
        In A, B;
        load(A, base, 0, wr, fr); load(B, base, 1, wr, fr);
        apply(A, acc, base, 0, wr, fr); load(A, base, 2, wr, fr);
        apply(B, acc, base, 1, wr, fr); load(B, base, 3, wr, fr);
        apply(A, acc, base, 2, wr, fr);
        apply(B, acc, base, 3, wr, fr);
    }
};
struct SubsetOrder {
    int nM, nN, nwg, G, c, split, skip; unsigned A, Bt, tileA, tileB;
    __device__ void init(unsigned A_, unsigned pitchA, unsigned Bt_, unsigned pitchB, int M, int nN_, int split_, int skip_, int G_, int c_) { A = A_; Bt = Bt_; tileA = 256u * pitchA; tileB = 256u * pitchB; nM = M / 256; nN = nN_; nwg = nM * nN; G = G_; c = c_; split = split_; skip = skip_; }
    __device__ bool next(int i, Unit& u) const {
        const long L = (long)i * G + c; if (L >= nwg) return false;
        int wgid = (int)L; { const int q = nwg / 8, r = nwg % 8, xcd = wgid % 8, off = wgid / 8; wgid = (xcd < r ? xcd * (q + 1) : r * (q + 1) + (xcd - r) * q) + off; }
        const int nig = 8 * nN, gid = wgid / nig, fm = gid * 8, gsz = (nM - fm) < 8 ? (nM - fm) : 8;
        u.pm = fm + ((wgid % nig) % gsz); const int j = (wgid % nig) / gsz; u.pn = j < split ? j : j + skip;
        u.a = A + (unsigned)u.pm * tileA; u.b = Bt + (unsigned)j * tileB; u.rows = nullptr; u.nvalid = 256; u.e = 0; u.pos0 = 0; u.chain = 0; return true;
    }
};
struct MoeSched1 {
    int unit; const LAS int* ebase; const int* LIST; unsigned A, B, Z;
    __device__ __forceinline__ bool next(int j, Unit& u) const {
        if (unit >= 256) return false;
        const int T = unit >> 1, pn = unit & 1, g0 = T * 256, g1 = g0 + 255; int e0 = 0, e1 = 0;
#pragma unroll
        for (int k = 1; k < 16; ++k) { const int b = __builtin_amdgcn_readfirstlane(ebase[k]); e0 += (b <= g0) ? 1 : 0; e1 += (b <= g1) ? 1 : 0; }
        const int e = e0 + j; if (e > e1) return false;
        const int lo = __builtin_amdgcn_readfirstlane(ebase[e]), hi = __builtin_amdgcn_readfirstlane(ebase[e + 1]);
        u.pm = T; u.pn = pn; u.e = e; u.pos0 = 0; u.nvalid = 256; u.chain = (e < e1) ? 1 : 0;
        u.rlo = (lo > g0 ? lo : g0) - g0; u.rhi = (hi < g1 + 1 ? hi : g1 + 1) - g0;
        u.rows = LIST + (size_t)e * ECAP + (g0 - lo);
        u.a = A; u.zoff = Z - A; u.b = B + (unsigned)(e * 512 + pn * 256) * 1024u;
        return true;
    }
};
struct MoeSched2 {
    int unit; const LAS int* cbase; unsigned HID, WD, Z;
    __device__ __forceinline__ bool next(int j, Unit& u) const {
        if (unit >= 256) return false;
        const int T = unit >> 2, pn = unit & 3, g0 = T * 256, g1 = g0 + 255; int c0 = 0, c1 = 0;
#pragma unroll
        for (int k = 1; k < 24; ++k) { const int b = __builtin_amdgcn_readfirstlane(cbase[k]); c0 += (b <= g0) ? 1 : 0; c1 += (b <= g1) ? 1 : 0; }
        const int cls = c0 + (j >> 1), plane = j & 1; if (cls > c1) return false;
        const int lo = __builtin_amdgcn_readfirstlane(cbase[cls]), hi = __builtin_amdgcn_readfirstlane(cbase[cls + 1]);
        const int g = cls / 6, p = cls - 6 * g, elo = (p >= 3 ? 1 : 0) + (p >= 5 ? 1 : 0), ehi = p + 1 - (p >= 3 ? 2 : 0) - (p >= 5 ? 1 : 0), e = 4 * g + (plane ? ehi : elo);
        u.pm = T; u.pn = pn; u.e = cls; u.pos0 = 0; u.nvalid = 256; u.rows = nullptr; u.chain = (cls < c1 || plane == 0) ? 1 : 0;
        u.rlo = (lo > g0 ? lo : g0) - g0; u.rhi = (hi < g1 + 1 ? hi : g1 + 1) - g0;
        u.a = HID + (unsigned)((size_t)plane * HPLANE + (size_t)T * 256 * 256); u.zoff = Z - u.a; u.b = WD + (unsigned)(e * 1024 + pn * 256) * 256u;
        return true;
    }
};
#ifndef TH2_EXPR
#define TH2_EXPR (2.f * m2 + 23.f * LOG2E)
#endif
#ifndef NOSKIP
#define NOSKIP 0
#endif
#ifndef DEFER_WGU
#define DEFER_WGU 1
#endif
#ifndef OUT_NT
#define OUT_NT 0
#endif
#ifndef GROUPSYNC
#define GROUPSYNC 0
#endif
#ifndef DEFER_WD
#define DEFER_WD 1
#endif
#ifndef FUSE_U
#define FUSE_U 1
#endif
#ifndef REPBAR
#define REPBAR 0
#endif
#ifndef P0I_REP
#define P0I_REP 1
#endif
#ifndef P0X_REP
#define P0X_REP 1
#endif
#ifndef ATT_REP
#define ATT_REP 1
#endif
#ifndef P1_FP8
#define P1_FP8 1
#endif
#ifndef XTRA_BAR
#define XTRA_BAR 0
#endif
#ifndef REP_P7
#define REP_P7 1
#endif
#ifndef REP_P0
#define REP_P0 1
#endif
#ifndef REP_P1
#define REP_P1 1
#endif
#ifndef REP_P2
#define REP_P2 1
#endif
#ifndef REP_P3
#define REP_P3 1
#endif
#ifndef REP_P4
#define REP_P4 1
#endif
#ifndef REP_P6A
#define REP_P6A 1
#endif
#ifndef REP_P6B
#define REP_P6B 1
#endif

__global__ void __launch_bounds__(NWAVES * 64, 2) hybrid_fwd(Args args) {
    extern __shared__ __attribute__((aligned(16))) unsigned char lds[];
    Frame F;
    F.lds = (LAS unsigned char*)lds;
    F.MISC = (volatile LAS unsigned*)(F.lds + MISC_OFF);
    F.wave = __builtin_amdgcn_readfirstlane((int)threadIdx.x >> 6); F.lane = lane_id(); F.tid = F.wave * 64 + F.lane;
    F.G = gridDim.x; { const int bx = blockIdx.x; F.vcu = (F.G % 8 == 0) ? (bx % 8) * (F.G / 8) + bx / 8 : bx; }
    unsigned char* ws = args.ws;
    F.ctl = (gu32*)(ws + WS_CTL);
    typedef const __attribute__((address_space(4))) char* kptr_t;
    kptr_t kargs = (kptr_t)__builtin_amdgcn_kernarg_segment_ptr();
#define KIN(i) (*(const float* const __attribute__((address_space(4)))*)(kargs + 8 * (i)))
#define KFENCE() asm volatile("" : "+s"(kargs))
#define in_x KIN(0)
#define p_in KIN(1)
#define g_attn KIN(2)
#define w_in KIN(3)
#define b_f KIN(4)
#define gq KIN(5)
#define gk KIN(6)
#define conv_w KIN(7)
#define w_oa KIN(8)
#define w_oc KIN(9)
#define w_o KIN(10)
#define g_ffn KIN(11)
#define w_rg KIN(12)
#define b_rg KIN(13)
#define w_re KIN(14)
#define b_re KIN(15)
#define w_gate KIN(16)
#define w_up KIN(17)
#define w_down KIN(18)
#define g_ple KIN(19)
#define w_pg KIN(20)
#define w_ple KIN(21)
    float* out = args.out;
    bf16* WIN = (bf16*)(ws + WS_WIN); bf16* WAB = (bf16*)(ws + WS_WAB); bf16* WO = (bf16*)(ws + WS_WO); bf16* WGU = (bf16*)(ws + WS_WGU); bf16* WD = (bf16*)(ws + WS_WD);
    bf16* WPG = (bf16*)(ws + WS_WPG); bf16* WPLE = (bf16*)(ws + WS_WPLE); bf16* WR = (bf16*)(ws + WS_WR);
    float* RSTD1 = (float*)(ws + WS_RSTD1); float* LF = (float*)(ws + WS_LF); float* CC = (float*)(ws + WS_C); float* SSQ2 = (float*)(ws + WS_SSQ2);
    float* RSTD2 = (float*)(ws + WS_RSTD2); int* LIST = (int*)(ws + WS_LIST); float* GATE = (float*)(ws + WS_GATE); int* INFO = (int*)(ws + WS_INFO); int* CLIST = (int*)(ws + WS_CLIST); float* SSQ3 = (float*)(ws + WS_SSQ3);
    bf16* XB = (bf16*)(ws + WS_XB); bf16* ACAT = (bf16*)(ws + WS_ACAT); bf16* HIDP = (bf16*)(ws + WS_HIDP);
    bf16* QB_ = (bf16*)(ws + WS_Q); bf16* KB_ = (bf16*)(ws + WS_K); bf16* VB_ = (bf16*)(ws + WS_V); bf16* MG = (bf16*)(ws + WS_MG); bf16* X1B = (bf16*)(ws + WS_X1B);
    bf16* CCU = (bf16*)(ws + WS_CCU); bf16* CB = (bf16*)(ws + WS_CB); bf16* UB = (bf16*)(ws + WS_U); bf16* RB = (bf16*)(ws + WS_R); bf16* SGB = (bf16*)(ws + WS_SGB);
    bf16* X2B = (bf16*)(ws + WS_X2B); bf16* PB = (bf16*)(ws + WS_PB); unsigned char* WIN8 = ws + WS_WIN8; unsigned char* XB8 = ws + WS_XB8; unsigned char* X1B8 = ws + WS_X1B8; unsigned char* X2B8 = ws + WS_X2B8;

    const wsrc_t WSR = __builtin_amdgcn_make_buffer_rsrc((void*)ws, (short)0, (int)WS_END, 0x00020000);
    for (int u = F.tid; u < (LDS_BYTES - LDSCTL_OFF) / 4; u += NWAVES * 64) ((LAS unsigned*)(F.lds + LDSCTL_OFF))[u] = 0u;
    __syncthreads();
    XcdBarrier bar = xcd_barrier_post((unsigned*)(F.ctl + CW_BAR), F.MISC + 8, F.tid);
#if CODE_PF && CODE_PF_ENTRY
    if (F.wave == 1 || F.wave == 2) {
        unsigned long long pc_; asm volatile("s_getpc_b64 %0" : "=s"(pc_));
        const unsigned long long a_ = (pc_ & ~255ULL) + (unsigned long long)((blockIdx.x >> 3) & 31u) * 1024u + (unsigned)(F.wave - 1) * 32768u / 2u * 0u + (unsigned)F.lane * 16u + (F.wave == 2 ? 32768u : 0u);
        __builtin_amdgcn_global_load_lds((const __attribute__((address_space(1))) void*)a_, (LAS void*)(F.lds + CODE_PF_DUMP + (F.wave - 1) * 1024), 16, 0, 0);
    }
#endif
#define REFRESH() do { int t_ = lane_id(); asm volatile("" : "+v"(t_)); F.lane = t_; F.tid = F.wave * 64 + t_; } while (0)
#ifdef PROBE_K
#define STAMP() do { if (blockIdx.x == 0 && F.tid == 0) { TSB[n_stamp] = rt(); } ++n_stamp; } while (0)
#else
#define STAMP() do {} while (0)
#endif
#ifdef TP_BAR
#ifndef TP_MODE
#define TP_MODE 0
#endif
#define TP_SPIN_() do { if (F.wave * 64 + lane_id() == 0) { LAS unsigned long long* tp_ = (LAS unsigned long long*)(F.lds + (LDS_BYTES - 64)); const unsigned long long now_ = rt(); const unsigned long long d_ = now_ - *tp_; while (rt() - now_ < d_) __builtin_amdgcn_s_sleep(4); } __syncthreads(); } while (0)
#define TP_WSPIN_() do { if (lane_id() == 0) { LAS unsigned long long* tp_ = (LAS unsigned long long*)(F.lds + (LDS_BYTES - 64)); const unsigned long long now_ = rt(); const unsigned long long d_ = now_ - *tp_; while (rt() - now_ < d_) __builtin_amdgcn_s_sleep(4); } } while (0)
#define TP_MARK() do { ++nb_; if (nb_ == TP_BAR - 1) { if (F.wave * 64 + lane_id() == 0) *(LAS unsigned long long*)(F.lds + (LDS_BYTES - 64)) = rt(); __syncthreads(); } else if (TP_MODE == 0 && nb_ == TP_BAR) TP_SPIN_(); } while (0)
#ifndef TP_SUBSET
#define TP_SUBSET 0
#endif
#define TP_INSUB_ (TP_SUBSET == 0 || (TP_SUBSET == 1 && blockIdx.x >= 128) || (TP_SUBSET == 2 && blockIdx.x >= 32 && blockIdx.x < 128) || (TP_SUBSET == 3 && blockIdx.x < 32))
#define TP_PRE() do { if (TP_MODE == 1 && nb_ + 1 == TP_BAR && TP_INSUB_) { __syncthreads(); TP_SPIN_(); } } while (0)
#else
#define TP_MARK() do {} while (0)
#define TP_PRE() do {} while (0)
#endif
#define GRID_BAR() do { TP_PRE(); xcd_barrier(bar, F.wave * 64 + lane_id()); TP_MARK(); KFENCE(); REFRESH(); STAMP(); } while (0)
#define GROUP_ARRIVE(word_) do { VM_WAIT(); __syncthreads(); if (F.wave * 64 + lane_id() == 0) { __builtin_amdgcn_fence(__ATOMIC_RELEASE, "agent"); VM_WAIT(); (void)xb_add((unsigned*)(F.ctl + (word_)), 1u); } } while (0)
#define GROUP_WAIT(word_, n_) do { if (F.wave * 64 + lane_id() == 0) { unsigned* w_ = (unsigned*)(F.ctl + (word_)); XB_SPIN(xb_ld(w_) < (unsigned)(n_), bar.bar); __builtin_amdgcn_fence(__ATOMIC_ACQUIRE, "agent"); VM_WAIT(); } __syncthreads(); KFENCE(); REFRESH(); } while (0)
    const int gw = F.vcu * NWAVES + F.wave, NGW = F.G * NWAVES;
#ifdef PROBE_K
    unsigned long long* TSB = (unsigned long long*)(ws + WS_RSTD3 + 128 * 1024); int n_stamp = 0; STAMP();
#endif
    const int NGT = F.G * NWAVES * 64;
#ifdef TP_BAR
    int nb_ = -1; TP_MARK();
#endif
#define gt (F.vcu * (NWAVES * 64) + F.tid)

    for (int xb_ = 0; xb_ < XTRA_BAR; ++xb_) GRID_BAR();
    for (int rep_ = 0; rep_ < REP_P0; ++rep_) {
    {
        LAS float* scr = (LAS float*)(F.lds + RING_OFF + F.wave * 16384);
        constexpr int I_WIN = 16 * 160, I_WAB = 16 * 32, I_WO = 16 * 32, I_WGU = 16 * 16 * 16, I_WD = 16 * 4 * 32, I_WPG = 16 * 32, I_WPLE = 4 * 32;
        constexpr int NITEMS = I_WIN + I_WAB + I_WO + I_WGU + I_WD + I_WPG + I_WPLE;
        struct Item { const float* src; const float* g; bf16* dst; int ld, Kd, drow, kd0, f8; float sc; unsigned char* dst8; };
        auto decode = [&](int it, Item& I) {
            int r = it;
            I.f8 = 0; I.sc = 32.f; I.dst8 = WIN8;
            if (r < I_WIN) { const int kb = r / 160, ng = r % 160, pn = ng >> 3; I.src = w_in + (size_t)(64 * kb) * PW_ + win_scol(ng); I.ld = PW_; I.g = g_attn + 64 * kb; I.dst = WIN; I.Kd = 1024; I.drow = ng * 32; I.kd0 = 64 * kb;
                if (P1_FP8 && (pn < 6 || pn >= 12)) { I.f8 = 1; I.drow = (pn < 6 ? pn : pn - 6) * 256 + (ng & 7) * 32; }
                return; } r -= I_WIN;
            if (r < I_WAB) { const int kb = r / 32, ng = r % 32; I.src = ((kb < 8) ? w_oa + (size_t)(64 * kb) * 1024 : w_oc + (size_t)(64 * (kb - 8)) * 1024) + 32 * ng; I.ld = 1024; I.g = nullptr; I.dst = WAB; I.Kd = 1024; I.drow = ng * 32; I.kd0 = 64 * kb; return; } r -= I_WAB;
            if (r < I_WO) { const int kb = r / 32, ng = r % 32; I.src = w_o + (size_t)(64 * kb) * 1024 + 32 * ng; I.ld = 1024; I.g = nullptr; I.dst = WO; I.Kd = 1024; I.drow = ng * 32; I.kd0 = 64 * kb; return; } r -= I_WO;
            if (r < I_WGU) { const int e = r / 256, kb = (r % 256) / 16, ng = r % 16, nt = ng >> 3, gidx = ng & 7, bj = gidx >> 2, wcc = gidx & 3;
                I.src = (bj ? w_up : w_gate) + (size_t)e * 1024 * 256 + (size_t)(64 * kb) * 256 + nt * 128 + 32 * wcc; I.ld = 256; I.g = g_ffn + 64 * kb; I.dst = WGU; I.f8 = 1; I.dst8 = (unsigned char*)WGU + (size_t)e * 512 * 1024; I.Kd = 1024; I.drow = ng * 32; I.kd0 = 64 * kb; return; } r -= I_WGU;
            if (r < I_WD) { const int e = r / 128, kb = (r % 128) / 32, ng = r % 32;
                I.src = w_down + (size_t)e * 256 * 1024 + (size_t)(64 * kb) * 1024 + 32 * ng; I.ld = 1024; I.g = nullptr; I.dst = WD; I.f8 = 1; I.sc = 16.f; I.dst8 = (unsigned char*)WD + (size_t)e * 1024 * 256; I.Kd = 256; I.drow = ng * 32; I.kd0 = 64 * kb; return; } r -= I_WD;
            if (r < I_WPG) { const int kb = r / 32, ng = r % 32; I.src = w_pg + (size_t)(64 * kb) * 1024 + 32 * ng; I.ld = 1024; I.g = g_ple + 64 * kb; I.dst = WPG; I.f8 = 1; I.dst8 = (unsigned char*)WPG; I.Kd = 1024; I.drow = ng * 32; I.kd0 = 64 * kb; return; } r -= I_WPG;
            { const int kb = r / 32, ng = r % 32; I.src = w_ple + (size_t)(64 * kb) * 1024 + 32 * ng; I.ld = 1024; I.g = nullptr; I.dst = WPLE; I.Kd = 256; I.drow = ng * 32; I.kd0 = 64 * kb; }
        };
        LAS unsigned char* wfh = F.lds + RING_OFF;
        for (int k = F.tid; k < 1024; k += NWAVES * 64) {
            const float* wp = w_in + (size_t)k * PW_ + OFF_F; const f32x4 w0 = *(const f32x4*)wp, w1 = *(const f32x4*)(wp + 4); const float g = g_attn[k];
            LAS unsigned char* d = wfh + (k >> 5) * 512 + ((k >> 3) & 3) * 128 + (k & 7) * 2;
#pragma unroll
            for (int h = 0; h < 8; ++h) { const float w = (h < 4 ? w0[h & 3] : w1[h & 3]) * g; const unsigned hi = f2bf(w); const unsigned lo = f2bf(w - __uint_as_float(hi << 16));
                *(LAS unsigned short*)(d + h * 16) = (unsigned short)hi; *(LAS unsigned short*)(d + 16384 + h * 16) = (unsigned short)lo; } }
        if (gt < 256) ((unsigned*)(ws + WS_ZERO))[gt] = 0u;
        for (int i = gt; i < 32 * 1024; i += NGT) { const int n = i >> 10, k = i & 1023; float v = 0.f;
            if (n < 4) v = w_rg[k * 4 + n] * g_ffn[k]; else if (n < 20) v = w_re[k * 16 + (n - 4)] * g_ffn[k];
            WR[i] = (bf16)f2bf(v); }
        __syncthreads();
#if defined(TP_BAR) && defined(TP_P0)
        if (TP_P0 == 1) { TP_SPIN_(); }
#endif
        if (F.wave < 4) {
            const int fr = F.lane & 15, fq = F.lane >> 4;
            const int row = (int)blockIdx.x * 64 + F.wave * 16 + fr;
            const float* xp = in_x + (size_t)row * 1024 + 8 * fq;
            const LAS unsigned char* wl = wfh + fq * 128 + (fr & 7) * 16;
            bf16* xbo = XB + (size_t)row * 1024 + 8 * fq; unsigned char* x8o = XB8 + (size_t)row * 1024 + 8 * fq;
            f32x4 acc = (f32x4){0.f, 0.f, 0.f, 0.f}; float ssq = 0.f;
            f32x4 va[8][2], vb[8][2];
#define XLOAD(dst, c_) do { _Pragma("unroll") for (int s_ = 0; s_ < 8; ++s_) { dst[s_][0] = *(const f32x4*)(xp + 32 * (8 * (c_) + s_)); dst[s_][1] = *(const f32x4*)(xp + 32 * (8 * (c_) + s_) + 4); } } while (0)
#define XPROC(src, c_) do { _Pragma("unroll") for (int s_ = 0; s_ < 8; ++s_) { const int ks_ = 8 * (c_) + s_; const f32x4 x0 = src[s_][0], x1 = src[s_][1]; \
                ssq += ((x0[0] * x0[0] + x0[1] * x0[1]) + (x0[2] * x0[2] + x0[3] * x0[3])) + ((x1[0] * x1[0] + x1[1] * x1[1]) + (x1[2] * x1[2] + x1[3] * x1[3])); \
                u32x4 hw; hw.x = cvt_pk_bf16(x0[0], x0[1]); hw.y = cvt_pk_bf16(x0[2], x0[3]); hw.z = cvt_pk_bf16(x1[0], x1[1]); hw.w = cvt_pk_bf16(x1[2], x1[3]); \
                u32x4 lw; lw.x = cvt_pk_bf16(x0[0] - bf_lo(hw.x), x0[1] - bf_hi(hw.x)); lw.y = cvt_pk_bf16(x0[2] - bf_lo(hw.y), x0[3] - bf_hi(hw.y)); \
                lw.z = cvt_pk_bf16(x1[0] - bf_lo(hw.z), x1[1] - bf_hi(hw.z)); lw.w = cvt_pk_bf16(x1[2] - bf_lo(hw.w), x1[3] - bf_hi(hw.w)); \
                const bf16x8 ah = *(const LAS bf16x8*)(wl + ks_ * 512), al = *(const LAS bf16x8*)(wl + 16384 + ks_ * 512); const bf16x8 xh = __builtin_bit_cast(bf16x8, hw), xl = __builtin_bit_cast(bf16x8, lw); \
                acc = __builtin_amdgcn_mfma_f32_16x16x32_bf16(ah, xh, acc, 0, 0, 0); acc = __builtin_amdgcn_mfma_f32_16x16x32_bf16(al, xh, acc, 0, 0, 0); acc = __builtin_amdgcn_mfma_f32_16x16x32_bf16(ah, xl, acc, 0, 0, 0); \
                *(u32x4*)(xbo + 32 * ks_) = hw; \
                int w0_ = __builtin_amdgcn_cvt_pk_fp8_f32(x0[0], x0[1], 0, false); w0_ = __builtin_amdgcn_cvt_pk_fp8_f32(x0[2], x0[3], w0_, true); \
                int w1_ = __builtin_amdgcn_cvt_pk_fp8_f32(x1[0], x1[1], 0, false); w1_ = __builtin_amdgcn_cvt_pk_fp8_f32(x1[2], x1[3], w1_, true); \
                *(pg8::u32x2*)(x8o + 32 * ks_) = (pg8::u32x2){(unsigned)w0_, (unsigned)w1_}; } } while (0)
            XLOAD(va, 0); XLOAD(vb, 1);
            XPROC(va, 0); XLOAD(va, 2);
            XPROC(vb, 1); XLOAD(vb, 3);
            XPROC(va, 2);
            XPROC(vb, 3);
#undef XLOAD
#undef XPROC
            ssq = xor16_add(ssq); ssq = xor32_add(ssq);
            const float rstd = 1.f / sqrtf(ssq * (1.f / 1024.f) + EPS_);
            if (fq == 0) RSTD1[row] = rstd;
            if (fq < 2) {
#pragma unroll
                for (int r = 0; r < 4; ++r) { const int h = 4 * fq + r; const float z = acc[r] * rstd + b_f[h]; const float ls = fminf(z, 0.f) - log1pf(expf(-fabsf(z)));
                    LF[((size_t)(row >> 12) * 8 + h) * SEQ_ + (row & (SEQ_ - 1))] = ls; } }
#if defined(TP_BAR) && defined(TP_P0)
            if (TP_P0 == 3) { VM_WAIT(); TP_WSPIN_(); }
#endif
        } else {
        const int n4 = 4 * (F.lane & 7), k8 = F.lane >> 3;
        const int igw = F.vcu * 4 + (F.wave - 4), INGW = F.G * 4;
        Item cur; f32x4 va[8], vb[8]; float ga[8], gb[8];
        {
        constexpr int SKIP_AT = I_WIN + I_WAB + I_WO;
#define ITEM_ID(i_) ((i_) < SKIP_AT ? (i_) : (i_) + (DEFER_WGU ? I_WGU : 0) + (DEFER_WD ? I_WD : 0))
#define NITEMS_P0 (NITEMS - (DEFER_WGU ? I_WGU : 0) - (DEFER_WD ? I_WD + I_WPLE : 0))
        int it = igw;
        if (it < NITEMS_P0) { decode(ITEM_ID(it), cur);
#pragma unroll
            for (int i = 0; i < 8; ++i) { va[i] = *(const f32x4*)(cur.src + (size_t)(k8 + 8 * i) * cur.ld + n4); ga[i] = cur.g ? cur.g[k8 + 8 * i] : 1.f; } }
        while (it < NITEMS_P0) {
            const int itn = it + INGW; Item nx = cur;
            if (itn < NITEMS_P0) { decode(ITEM_ID(itn), nx);
#pragma unroll
                for (int i = 0; i < 8; ++i) { vb[i] = *(const f32x4*)(nx.src + (size_t)(k8 + 8 * i) * nx.ld + n4); gb[i] = nx.g ? nx.g[k8 + 8 * i] : 1.f; } }
#pragma unroll
            for (int i = 0; i < 8; ++i) { LAS float* d = scr + (k8 + 8 * i) * 33 + n4; const f32x4 v = va[i] * ga[i]; d[0] = v[0]; d[1] = v[1]; d[2] = v[2]; d[3] = v[3]; }
            LDS_WAIT(); asm volatile("" ::: "memory");
            { const int c = F.lane & 7;
#pragma unroll
              for (int j = 0; j < 4; ++j) { const int n = (F.lane >> 3) + 8 * j; const LAS float* s = scr + (8 * c) * 33 + n;
                if (cur.f8) { const float sc = cur.sc; int w0 = __builtin_amdgcn_cvt_pk_fp8_f32(s[0 * 33] * sc, s[1 * 33] * sc, 0, false); w0 = __builtin_amdgcn_cvt_pk_fp8_f32(s[2 * 33] * sc, s[3 * 33] * sc, w0, true);
                    int w1 = __builtin_amdgcn_cvt_pk_fp8_f32(s[4 * 33] * sc, s[5 * 33] * sc, 0, false); w1 = __builtin_amdgcn_cvt_pk_fp8_f32(s[6 * 33] * sc, s[7 * 33] * sc, w1, true);
                    *(unsigned long long*)(cur.dst8 + (size_t)(cur.drow + n) * cur.Kd + cur.kd0 + 8 * c) = (unsigned long long)(unsigned)w0 | ((unsigned long long)(unsigned)w1 << 32); }
                else { v4u o; o.x = pk2(s[0 * 33], s[1 * 33]); o.y = pk2(s[2 * 33], s[3 * 33]); o.z = pk2(s[4 * 33], s[5 * 33]); o.w = pk2(s[6 * 33], s[7 * 33]);
                    WTS(WSR, (unsigned)((const char*)(cur.dst + (size_t)(cur.drow + n) * cur.Kd + cur.kd0 + 8 * c) - (const char*)ws), o); } } }
            LDS_WAIT(); asm volatile("" ::: "memory");
            cur = nx; it = itn;
#pragma unroll
            for (int i = 0; i < 8; ++i) { va[i] = vb[i]; ga[i] = gb[i]; }
        }
        }
        for (int m = igw * 4; m < NTOK; m += INGW * 4) { f32x4 pv[4];
#pragma unroll
            for (int j = 0; j < 4; ++j) pv[j] = *((const f32x4*)(p_in + (size_t)(m + j) * 256) + F.lane);
#pragma unroll
            for (int j = 0; j < 4; ++j) *((unsigned long long*)(PB + (size_t)(m + j) * 256) + F.lane) = (unsigned long long)pk2(pv[j][0], pv[j][1]) | ((unsigned long long)pk2(pv[j][2], pv[j][3]) << 32); }
#if defined(TP_BAR) && defined(TP_P0)
            if (TP_P0 == 4) { VM_WAIT(); TP_WSPIN_(); }
#endif
        }
    }
    __syncthreads(); }
    GRID_BAR();
    if (blockIdx.x < NB_ * NH_) {
        const int bh = blockIdx.x; const float* lf = LF + (size_t)bh * SEQ_ + F.tid * 8; float v[8]; float s = 0.f;
        const f32x4 a = *(const f32x4*)lf, b = *(const f32x4*)(lf + 4);
        v[0] = a[0]; v[1] = a[1]; v[2] = a[2]; v[3] = a[3]; v[4] = b[0]; v[5] = b[1]; v[6] = b[2]; v[7] = b[3];
#pragma unroll
        for (int j = 0; j < 8; ++j) { s += v[j]; v[j] = s; }
        float incl = s;
#pragma unroll
        for (int o = 1; o < 64; o <<= 1) { const float t = __shfl_up(incl, o); if (F.lane >= o) incl += t; }
        LAS float* wt = (LAS float*)(F.lds + RING_OFF);
        if (F.lane == 63) wt[F.wave] = incl;
        __syncthreads();
        float base = incl - s;
        for (int w = 0; w < F.wave; ++w) base += wt[w];
        float* co = CC + (size_t)bh * SEQ_ + F.tid * 8;
        *(f32x4*)co = (f32x4){base + v[0], base + v[1], base + v[2], base + v[3]}; *(f32x4*)(co + 4) = (f32x4){base + v[4], base + v[5], base + v[6], base + v[7]};
    }
    __syncthreads();
    for (int rep_ = 0; rep_ < REP_P1; ++rep_) {
    {
#if P1_FP8
        { SubsetOrder S; S.init((unsigned)WS_XB8, 1024u, (unsigned)WS_WIN8, 1024u, NTOK, 14, 6, 6, F.G, (int)blockIdx.x);
          EpiP1 E{RSTD1, gq, gk, WSR, (unsigned)WS_Q, (unsigned)WS_K, (unsigned)WS_V, (unsigned)WS_CCU, (unsigned)WS_CB, ws + WS_R, ws + WS_SGB, 1.f / 32.f};
          pg8::gemm_phase<EpiP1, SubsetOrder, true, 0, false, true>(F.lds + RING_OFF, WSR, F.wave, 1024, S, E); }
        { SubsetOrder S; S.init((unsigned)WS_XB, 2048u, (unsigned)(WS_WIN + (size_t)6 * 256 * 2048), 2048u, NTOK, 6, 0, 6, F.G, (int)(((blockIdx.x & ~7u) ^ (unsigned)(F.G - 8)) | (blockIdx.x & 7u)));
          EpiP1 E{RSTD1, gq, gk, WSR, (unsigned)WS_Q, (unsigned)WS_K, (unsigned)WS_V, (unsigned)WS_CCU, (unsigned)WS_CB, ws + WS_R, ws + WS_SGB, 1.f};
          pg8::gemm_phase<EpiP1, SubsetOrder, true, 0, false, false>(F.lds + RING_OFF, WSR, F.wave, 1024, S, E); }
#else
        { SubsetOrder S; S.init((unsigned)WS_XB, 2048u, (unsigned)WS_WIN, 2048u, NTOK, 20, 20, 0, F.G, (int)blockIdx.x);
          EpiP1 E{RSTD1, gq, gk, WSR, (unsigned)WS_Q, (unsigned)WS_K, (unsigned)WS_V, (unsigned)WS_CCU, (unsigned)WS_CB, ws + WS_R, ws + WS_SGB, 1.f};
          pg8::gemm_phase<EpiP1, SubsetOrder, true, 0, false, false>(F.lds + RING_OFF, WSR, F.wave, 1024, S, E); }
#endif
#if DEFER_WGU
        if (blockIdx.x < 128) {
            LAS float* scr = (LAS float*)(F.lds + RING_OFF + F.wave * 16384);
            const int lane = lane_id(), n4 = 4 * (lane & 7), k8 = lane >> 3, c8 = lane & 7;
            f32x4 v[4][8]; float gs[4][8];
#pragma unroll
            for (int q = 0; q < 4; ++q) { const int r = (int)blockIdx.x * NWAVES + F.wave + q * (128 * NWAVES);
                const int e = r >> 8, kb = (r >> 4) & 15, ng = r & 15, nt = ng >> 3, gidx = ng & 7, bj = gidx >> 2, wcc = gidx & 3;
                const float* src = (bj ? w_up : w_gate) + (size_t)e * 1024 * 256 + (size_t)(64 * kb) * 256 + nt * 128 + 32 * wcc; const float* gg = g_ffn + 64 * kb;
#pragma unroll
                for (int i = 0; i < 8; ++i) { v[q][i] = *(const f32x4*)(src + (size_t)(k8 + 8 * i) * 256 + n4); gs[q][i] = gg[k8 + 8 * i] * 32.f; } }
#pragma unroll
            for (int q = 0; q < 4; ++q) { const int r = (int)blockIdx.x * NWAVES + F.wave + q * (128 * NWAVES);
                const int e = r >> 8, kb = (r >> 4) & 15, ng = r & 15;
#pragma unroll
                for (int i = 0; i < 8; ++i) { LAS float* d = scr + (k8 + 8 * i) * 33 + n4; const f32x4 w = v[q][i] * gs[q][i]; d[0] = w[0]; d[1] = w[1]; d[2] = w[2]; d[3] = w[3]; }
                LDS_WAIT(); asm volatile("" ::: "memory");
                unsigned char* dst = (unsigned char*)WGU + (size_t)e * 512 * 1024 + (size_t)(ng * 32) * 1024 + 64 * kb + 8 * c8;
#pragma unroll
                for (int j = 0; j < 4; ++j) { const int n = (lane >> 3) + 8 * j; const LAS float* s = scr + (8 * c8) * 33 + n;
                    int w0 = __builtin_amdgcn_cvt_pk_fp8_f32(s[0 * 33], s[1 * 33], 0, false); w0 = __builtin_amdgcn_cvt_pk_fp8_f32(s[2 * 33], s[3 * 33], w0, true);
                    int w1 = __builtin_amdgcn_cvt_pk_fp8_f32(s[4 * 33], s[5 * 33], 0, false); w1 = __builtin_amdgcn_cvt_pk_fp8_f32(s[6 * 33], s[7 * 33], w1, true);
                    *(unsigned long long*)(dst + (size_t)n * 1024) = (unsigned long long)(unsigned)w0 | ((unsigned long long)(unsigned)w1 << 32); }
                LDS_WAIT(); asm volatile("" ::: "memory");
            }
#if DEFER_WD == 2
            {
            constexpr int NIT = 16 * 4 * 32 + 4 * 32;
            f32x4 v2[3][8];
#pragma unroll
            for (int q = 0; q < 3; ++q) { const int r = (int)blockIdx.x * NWAVES + F.wave + q * 1024;
                if (r < NIT) { const bool ple = r >= 16 * 4 * 32; const int qq = ple ? r - 16 * 4 * 32 : r, e = qq >> 7, kb = (qq >> 5) & 3, ng = qq & 31;
                    const float* src = (ple ? w_ple : w_down + (size_t)e * 256 * 1024) + (size_t)(64 * kb) * 1024 + 32 * ng;
#pragma unroll
                    for (int i = 0; i < 8; ++i) v2[q][i] = *(const f32x4*)(src + (size_t)(k8 + 8 * i) * 1024 + n4); } }
#pragma unroll
            for (int q = 0; q < 3; ++q) { const int r = (int)blockIdx.x * NWAVES + F.wave + q * 1024;
                if (r < NIT) { const bool ple = r >= 16 * 4 * 32; const int qq = ple ? r - 16 * 4 * 32 : r, e = qq >> 7, kb = (qq >> 5) & 3, ng = qq & 31;
                const float sc = ple ? 1.f : 16.f;
#pragma unroll
                for (int i = 0; i < 8; ++i) { LAS float* d = scr + (k8 + 8 * i) * 33 + n4; const f32x4 w = v2[q][i] * sc; d[0] = w[0]; d[1] = w[1]; d[2] = w[2]; d[3] = w[3]; }
                LDS_WAIT(); asm volatile("" ::: "memory");
#pragma unroll
                for (int j = 0; j < 4; ++j) { const int n = (lane >> 3) + 8 * j; const LAS float* s = scr + (8 * c8) * 33 + n;
                    if (ple) { v4u o; o.x = pk2(s[0 * 33], s[1 * 33]); o.y = pk2(s[2 * 33], s[3 * 33]); o.z = pk2(s[4 * 33], s[5 * 33]); o.w = pk2(s[6 * 33], s[7 * 33]);
                        *(v4u*)(WPLE + (size_t)(ng * 32 + n) * 256 + 64 * kb + 8 * c8) = o; }
                    else { int w0 = __builtin_amdgcn_cvt_pk_fp8_f32(s[0 * 33], s[1 * 33], 0, false); w0 = __builtin_amdgcn_cvt_pk_fp8_f32(s[2 * 33], s[3 * 33], w0, true);
                        int w1 = __builtin_amdgcn_cvt_pk_fp8_f32(s[4 * 33], s[5 * 33], 0, false); w1 = __builtin_amdgcn_cvt_pk_fp8_f32(s[6 * 33], s[7 * 33], w1, true);
                        *(unsigned long long*)((unsigned char*)WD + (size_t)e * 1024 * 256 + (size_t)(ng * 32 + n) * 256 + 64 * kb + 8 * c8) = (unsigned long long)(unsigned)w0 | ((unsigned long long)(unsigned)w1 << 32); } }
                LDS_WAIT(); asm volatile("" ::: "memory");
                } }
            }
#endif
        }
#endif
    }
    __syncthreads(); }
    GRID_BAR();
    for (int rep_ = 0; rep_ < REP_P2; ++rep_) {
    for (int g2 = gt; g2 < (NTOK / 8) * 64; g2 += NGT) {
        const int ch0 = (g2 & 63) * 8, t0 = (g2 >> 6) * 8; const bool first = (t0 & (SEQ_ - 1)) == 0;
        const u32x4 z4 = (u32x4){0u, 0u, 0u, 0u};
        u32x4 cu[10], cv[8];
        cu[0] = first ? z4 : *(const u32x4*)(CCU + (size_t)(t0 - 2) * 512 + ch0); cu[1] = first ? z4 : *(const u32x4*)(CCU + (size_t)(t0 - 1) * 512 + ch0);
#pragma unroll
        for (int i = 0; i < 8; ++i) { cu[2 + i] = *(const u32x4*)(CCU + (size_t)(t0 + i) * 512 + ch0); cv[i] = *(const u32x4*)(CB + (size_t)(t0 + i) * 512 + ch0); }
        const f32x4 w0a = *(const f32x4*)(conv_w + ch0), w0b = *(const f32x4*)(conv_w + ch0 + 4), w1a = *(const f32x4*)(conv_w + 512 + ch0), w1b = *(const f32x4*)(conv_w + 512 + ch0 + 4),
                    w2a = *(const f32x4*)(conv_w + 1024 + ch0), w2b = *(const f32x4*)(conv_w + 1024 + ch0 + 4);
        f32x4 u0a, u0b, u1a, u1b; unpack8(cu[0], u0a, u0b); unpack8(cu[1], u1a, u1b);
#pragma unroll
        for (int i = 0; i < 8; ++i) { f32x4 u2a, u2b, ca, cb_; unpack8(cu[2 + i], u2a, u2b); unpack8(cv[i], ca, cb_);
            WTS(WSR, (unsigned)WS_ACAT + (unsigned)((size_t)(t0 + i) * 1024 + 512 + ch0) * 2u, pack8(ca * (w0a * u0a + w1a * u1a + w2a * u2a), cb_ * (w0b * u0b + w1b * u1b + w2b * u2b)));
            u0a = u1a; u0b = u1b; u1a = u2a; u1b = u2b; }
    }
    {
        float mq = 0.f, mk = 0.f;
        for (int i = 0; i < 64; ++i) { mq = fmaxf(mq, fabsf(gq[i])); mk = fmaxf(mk, fabsf(gk[i])); }
        const float m2 = QC2 * 64.f * mq * mk, th2 = TH2_EXPR;
        LAS float* cE = (LAS float*)(F.lds + RING_OFF + attn_body::LDS_BYTES);
        LAS int* ucost = (LAS int*)(F.lds + RING_OFF + attn_body::LDS_BYTES + 8192);
        LAS int* bhc = ucost + 512;
        LAS int* nj = bhc + 32;
        LAS int* sj = nj + 16;
        for (int i = F.tid; i < 2048; i += NWAVES * 64) cE[i] = CC[(size_t)(i >> 6) * SEQ_ + (i & 63) * 64 + 63];
        if (F.tid < 32) bhc[F.tid] = 0;
        __syncthreads();
        { const int uid = F.tid, bh = uid >> 4, qb = uid & 15, NT = 4 * (qb + 1);
          const float cq0 = CC[(size_t)bh * SEQ_ + qb * 256]; int t0 = 0;
          for (int j = 0; j < NT - 4; ++j) { if ((cq0 - cE[bh * 64 + j]) * LOG2E < -th2) t0 = j + 1; }
          t0 &= ~1; if (NOSKIP) t0 = 0; ucost[uid] = ((NT - t0) << 8) | t0;
          __hip_atomic_fetch_add(bhc + bh, NT - t0 + 5, __ATOMIC_RELAXED, __HIP_MEMORY_SCOPE_WORKGROUP); }
        __syncthreads();
        if (F.tid < 32) { const int mine = bhc[F.tid]; int rank = 0;
            for (int j = 0; j < 32; ++j) { const int o = bhc[j]; rank += (o > mine || (o == mine && j < F.tid)) ? 1 : 0; }
            sj[rank] = F.tid; }
        __syncthreads();
        LAS float* ct = (LAS float*)(F.lds + RING_OFF + attn_body::LDS_CT);
        const int slot = F.vcu >> 4, me = F.vcu & 15;
        for (int kk = 0; kk < 2 * ATT_REP; ++kk) { const int k = kk & 1;
            const int bh = __builtin_amdgcn_readfirstlane(sj[k ? 31 - slot : slot]), qb = (k & 1) ? 15 - me : me, t0 = __builtin_amdgcn_readfirstlane(ucost[bh * 16 + qb]) & 255;
            { const int t_ = F.wave * 64 + lane_id();
              for (int i = t_; i < SEQ_; i += NWAVES * 64) ct[i] = -CC[(size_t)bh * SEQ_ + i] * LOG2E; }
            __syncthreads();
            attn_body::attn_unit(bh >> 3, bh & 7, qb, t0, m2, (const attn_body::bf16*)QB_, (const attn_body::bf16*)KB_, (const attn_body::bf16*)VB_, (attn_body::bf16*)ACAT, (char*)lds + RING_OFF, WSR, (const char*)ws, F.wave);
        }
    }
    __syncthreads(); }
    GRID_BAR();
    for (int rep_ = 0; rep_ < REP_P3; ++rep_) {
    {
        pg8::StaticOrder S; S.init((unsigned)WS_ACAT, (unsigned)WS_WAB, NTOK, 1024, 1024, F.G, (int)blockIdx.x);
        EpiMerged E{ws + WS_R, ws + WS_SGB, WSR, (unsigned)WS_MG};
        pg8::gemm_phase<EpiMerged, pg8::StaticOrder, true, 0, true>(F.lds + RING_OFF, WSR, F.wave, 1024, S, E);
#if GROUPSYNC
        { pg8::Unit u0; S.next(0, u0); const int gword = CW_G3 + 64 * u0.pm; GROUP_ARRIVE(gword); GROUP_WAIT(gword, 4); }
#endif
    }
    __syncthreads(); }
#if !GROUPSYNC
    GRID_BAR();
#endif
    for (int rep_ = 0; rep_ < REP_P4; ++rep_) {
    {
        pg8::StaticOrder S; S.init((unsigned)WS_MG, (unsigned)WS_WO, NTOK, 1024, 1024, F.G, (int)blockIdx.x);
        EpiX1 E{XB, WSR, (unsigned)WS_X1B, SSQ2, X1B8};
        pg8::gemm_phase<EpiX1, pg8::StaticOrder, true, 0, false>(F.lds + RING_OFF, WSR, F.wave, 1024, S, E);
#if GROUPSYNC
        { pg8::Unit u0; S.next(0, u0); GROUP_ARRIVE(CW_G4 + 64 * u0.pm); GROUP_WAIT(CW_G4 + 64 * ((int)blockIdx.x >> 2), 4); }
#endif
    }
    __syncthreads(); }
#if !GROUPSYNC
    GRID_BAR();
#endif
    {
        LAS float* lg = (LAS float*)(F.lds + RING_OFF);
        LAS int* lcnt = (LAS int*)(F.lds + RING_OFF + 8192);
        LAS unsigned char* wrl = F.lds + RING_OFF + 16384;
        if (F.tid < 40) lcnt[F.tid] = 0;
        for (int i = F.tid; i < 32 * 128; i += NWAVES * 64) { const int n = i >> 7, c = i & 127; *(LAS v4u*)(wrl + n * 2064 + c * 16) = *(const v4u*)(WR + (size_t)n * 1024 + c * 8); }
        __syncthreads();
        const int fr = F.lane & 15, fq = F.lane >> 4;
        int e0 = 0, e1 = 0, cls = 0, rk0 = 0, rk1 = 0, rkc = 0; float w0 = 0.f, w1 = 0.f; const int tok = blockIdx.x * 64 + F.wave * 16 + F.lane;
        if (F.wave < 4) {
            const int r0 = blockIdx.x * 64 + F.wave * 16;
            f32x4 a0 = (f32x4){0.f, 0.f, 0.f, 0.f}, a1 = a0;
            const bf16* xrow = X1B + (size_t)(r0 + fr) * 1024 + 8 * fq; const LAS unsigned char* wl0 = wrl + fr * 2064 + 16 * fq; const LAS unsigned char* wl1 = wrl + (16 + fr) * 2064 + 16 * fq;
#pragma unroll
            for (int hb = 0; hb < 2; ++hb) { bf16x8 bx[16];
#pragma unroll
                for (int k = 0; k < 16; ++k) bx[k] = *(const bf16x8*)(xrow + 32 * (16 * hb + k));
#pragma unroll
                for (int k = 0; k < 16; ++k) { const int ks = 16 * hb + k; const bf16x8 wa = *(const LAS bf16x8*)(wl0 + 64 * ks), wb = *(const LAS bf16x8*)(wl1 + 64 * ks);
                    a0 = __builtin_amdgcn_mfma_f32_16x16x32_bf16(wa, bx[k], a0, 0, 0, 0); a1 = __builtin_amdgcn_mfma_f32_16x16x32_bf16(wb, bx[k], a1, 0, 0, 0); } }
            LAS float* lw = lg + F.wave * 512 + fr * 32;
#pragma unroll
            for (int r = 0; r < 4; ++r) { lw[4 * fq + r] = a0[r]; lw[16 + 4 * fq + r] = a1[r]; }
            LDS_WAIT(); asm volatile("" ::: "memory");
            if (F.lane < 16) {
                float ssq = 0.f;
#pragma unroll
                for (int i = 0; i < 16; ++i) ssq += SSQ2[(size_t)tok * 16 + i];
                const float rs = 1.f / sqrtf(ssq * (1.f / 1024.f) + EPS_);
                RSTD2[tok] = rs;
                const LAS float* l = lg + F.wave * 512 + F.lane * 32;
                float gmax = -3e38f; int gi = 0;
#pragma unroll
                for (int i = 0; i < 4; ++i) { const float v = l[i] * rs + b_rg[i]; if (v > gmax) { gmax = v; gi = i; } }
                float gs = 0.f;
#pragma unroll
                for (int i = 0; i < 4; ++i) gs += expf(l[i] * rs + b_rg[i] - gmax);
                const float gval = 1.f / gs;
                float m0 = -3e38f, m1 = -3e38f; int i0 = 0, i1 = 0;
#pragma unroll
                for (int i = 0; i < 4; ++i) { const float v = l[4 + gi * 4 + i] * rs + b_re[gi * 4 + i];
                    if (v > m0) { m1 = m0; i1 = i0; m0 = v; i0 = i; } else if (v > m1) { m1 = v; i1 = i; } }
                const float p1 = expf(m1 - m0);
                w0 = gval / (1.f + p1); w1 = gval * p1 / (1.f + p1); e0 = gi * 4 + i0; e1 = gi * 4 + i1;
                const int ilo = i0 < i1 ? i0 : i1, ihi = i0 < i1 ? i1 : i0;
                cls = gi * 6 + ((ilo == 0) ? ihi - 1 : (ilo == 1) ? ihi + 1 : 5);
                rk0 = __hip_atomic_fetch_add(lcnt + e0, 1, __ATOMIC_RELAXED, __HIP_MEMORY_SCOPE_WORKGROUP);
                rk1 = __hip_atomic_fetch_add(lcnt + e1, 1, __ATOMIC_RELAXED, __HIP_MEMORY_SCOPE_WORKGROUP);
                rkc = __hip_atomic_fetch_add(lcnt + 16 + cls, 1, __ATOMIC_RELAXED, __HIP_MEMORY_SCOPE_WORKGROUP);
            }
        }
#if DEFER_WD == 1
        else {
            static_assert(DEFER_WGU, "item numbering assumes the gate/up weights are deferred too");
            LAS float* scr = (LAS float*)(F.lds + RING_OFF + 83968 + (F.wave - 4) * 8704);
            const int lane = lane_id(), n4 = 4 * (lane & 7), k8 = lane >> 3, c8 = lane & 7;
            for (int r = (int)blockIdx.x * 4 + (F.wave - 4); r < 16 * 4 * 32 + 4 * 32; r += (int)F.G * 4) {
                const bool ple = r >= 16 * 4 * 32; const int q = ple ? r - 16 * 4 * 32 : r, e = q >> 7, kb = (q >> 5) & 3, ng = q & 31;
                const float* src = (ple ? w_ple : w_down + (size_t)e * 256 * 1024) + (size_t)(64 * kb) * 1024 + 32 * ng;
                f32x4 v[8];
#pragma unroll
                for (int i = 0; i < 8; ++i) v[i] = *(const f32x4*)(src + (size_t)(k8 + 8 * i) * 1024 + n4);
                const float sc = ple ? 1.f : 16.f;
#pragma unroll
                for (int i = 0; i < 8; ++i) { LAS float* d = scr + (k8 + 8 * i) * 33 + n4; const f32x4 w = v[i] * sc; d[0] = w[0]; d[1] = w[1]; d[2] = w[2]; d[3] = w[3]; }
                LDS_WAIT(); asm volatile("" ::: "memory");
#pragma unroll
                for (int j = 0; j < 4; ++j) { const int n = (lane >> 3) + 8 * j; const LAS float* s = scr + (8 * c8) * 33 + n;
                    if (ple) { v4u o; o.x = pk2(s[0 * 33], s[1 * 33]); o.y = pk2(s[2 * 33], s[3 * 33]); o.z = pk2(s[4 * 33], s[5 * 33]); o.w = pk2(s[6 * 33], s[7 * 33]);
                        *(v4u*)(WPLE + (size_t)(ng * 32 + n) * 256 + 64 * kb + 8 * c8) = o; }
                    else { int w0 = __builtin_amdgcn_cvt_pk_fp8_f32(s[0 * 33], s[1 * 33], 0, false); w0 = __builtin_amdgcn_cvt_pk_fp8_f32(s[2 * 33], s[3 * 33], w0, true);
                        int w1 = __builtin_amdgcn_cvt_pk_fp8_f32(s[4 * 33], s[5 * 33], 0, false); w1 = __builtin_amdgcn_cvt_pk_fp8_f32(s[6 * 33], s[7 * 33], w1, true);
                        *(unsigned long long*)((unsigned char*)WD + (size_t)e * 1024 * 256 + (size_t)(ng * 32 + n) * 256 + 64 * kb + 8 * c8) = (unsigned long long)(unsigned)w0 | ((unsigned long long)(unsigned)w1 << 32); } }
                LDS_WAIT(); asm volatile("" ::: "memory");
            }
        }
#endif
        __syncthreads();
        if (F.tid < 40) { const int c = lcnt[F.tid]; lcnt[64 + F.tid] = c ? (int)__hip_atomic_fetch_add((unsigned*)(F.ctl + CW_CNT + 64 * F.tid), (unsigned)c, __ATOMIC_RELAXED, __HIP_MEMORY_SCOPE_AGENT) : 0; }
        __syncthreads();
        if (F.wave < 4 && F.lane < 16) {
            const int p0 = lcnt[64 + e0] + rk0, p1 = lcnt[64 + e1] + rk1, pc = lcnt[64 + 16 + cls] + rkc;
            LIST[(size_t)e0 * ECAP + p0] = tok * 2; GATE[(size_t)e0 * ECAP + p0] = w0; INFO[(size_t)e0 * ECAP + p0] = (cls << 20) | (pc << 1) | (e0 < e1 ? 0 : 1);
            LIST[(size_t)e1 * ECAP + p1] = tok * 2 + 1; GATE[(size_t)e1 * ECAP + p1] = w1; INFO[(size_t)e1 * ECAP + p1] = (cls << 20) | (pc << 1) | (e1 < e0 ? 0 : 1);
            CLIST[(size_t)cls * ECAP + pc] = tok;
        }
        __syncthreads();
    }
    GRID_BAR();
    LAS int* ebase = (LAS int*)(F.lds + MOE_TAB_OFF); LAS int* cbase = ebase + 64;
    for (int rep_ = 0; rep_ < REP_P6A; ++rep_) {
    {
        LAS int* craw = ebase + 128;
        if (F.tid < 40) craw[F.tid] = (int)__hip_atomic_load((unsigned*)(F.ctl + CW_CNT + 64 * F.tid), __ATOMIC_RELAXED, __HIP_MEMORY_SCOPE_AGENT);
        __syncthreads();
        if (F.tid < 17) { int a = 0; for (int e = 0; e < 16; ++e) a += (e < F.tid) ? craw[e] : 0; ebase[F.tid] = a; }
        else if (F.tid >= 64 && F.tid < 89) { const int c0 = F.tid - 64; int a = 0; for (int c = 0; c < 24; ++c) a += (c < c0) ? craw[16 + c] : 0; cbase[c0] = a; }
        __syncthreads();
        MoeSched1 S{F.vcu, ebase, LIST, (unsigned)WS_X1B8, (unsigned)WS_WGU, (unsigned)WS_ZERO};
        EpiHid E{RSTD2, LIST, GATE, INFO, (unsigned char*)HIDP, ebase, cbase};
        pg8::gemm_phase<EpiHid, MoeSched1, true, 1, false, true>(F.lds + RING_OFF, WSR, F.wave, 1024, S, E);
    }
#if !FUSE_U
    {
        pg8::StaticOrder S; S.init((unsigned)WS_PB, (unsigned)WS_WPLE, NTOK, 1024, 256, F.G, (int)blockIdx.x);
        EpiPlain E{WSR, (unsigned)WS_U, 1024};
        pg8::gemm_phase<EpiPlain, pg8::StaticOrder, true, 0, false>(F.lds + RING_OFF, WSR, F.wave, 256, S, E);
    }
#endif
    __syncthreads(); }
    GRID_BAR();
    for (int rep_ = 0; rep_ < REP_P6B; ++rep_) {
    {
        MoeSched2 S{F.vcu, cbase, (unsigned)WS_HIDP, (unsigned)WS_WD, (unsigned)WS_ZERO};
        EpiX2 E{X1B, WSR, (unsigned)WS_X2B, SSQ3, X2B8, CLIST, cbase};
        pg8::gemm_phase<EpiX2, MoeSched2, true, 2, false, true>(F.lds + RING_OFF, WSR, F.wave, 256, S, E);
    }
    __syncthreads();
#if REPBAR
    if (rep_ + 1 < REP_P6B) GRID_BAR();
#endif
    }
    GRID_BAR();
    for (int rep_ = 0; rep_ < REP_P7; ++rep_) {
    {
        pg8::StaticOrder S; S.init((unsigned)WS_X2B8, (unsigned)WS_WPG, NTOK, 1024, 1024, F.G, (int)blockIdx.x, 1);
        LAS float* rsl = (LAS float*)(F.lds + MOE_TAB_OFF + 1024);
        { pg8::Unit u0; if (S.next(0, u0) && F.tid < 256) { const f32x4* sp = (const f32x4*)(SSQ3 + (size_t)(u0.pm * 256 + F.tid) * 16); const f32x4 s0 = sp[0], s1 = sp[1], s2 = sp[2], s3 = sp[3];
              const float ssq = ((s0[0] + s0[1]) + (s0[2] + s0[3])) + ((s1[0] + s1[1]) + (s1[2] + s1[3])) + ((s2[0] + s2[1]) + (s2[2] + s2[3])) + ((s3[0] + s3[1]) + (s3[2] + s3[3]));
              rsl[F.tid] = (1.f / 32.f) / sqrtf(ssq * (1.f / 1024.f) + EPS_); } }
        __syncthreads();
#if FUSE_U
        unsigned gst[32];
        { EpiGate E{rsl, gst};
          pg8::gemm_phase<EpiGate, pg8::StaticOrder, true, 0, false, true>(F.lds + RING_OFF, WSR, F.wave, 1024, S, E); }
        { pg8::StaticOrder SU; SU.init((unsigned)WS_PB, (unsigned)WS_WPLE, NTOK, 1024, 256, F.G, (int)blockIdx.x);
          EpiFinalU E{X2B, out, gst};
          pg8::gemm_phase<EpiFinalU, pg8::StaticOrder, true, 0, false, false>(F.lds + RING_OFF, WSR, F.wave, 256, SU, E); }
#else
        EpiFinal E{rsl, X2B, UB, out};
        pg8::gemm_phase<EpiFinal, pg8::StaticOrder, true, 0, false, true>(F.lds + RING_OFF, WSR, F.wave, 1024, S, E);
#endif
    }
    __syncthreads(); }
#ifdef TP_BAR
    if (TP_BAR == 9) { __syncthreads(); TP_SPIN_(); }
#endif
}

extern "C" void kernel_launch(void* const* d_in, const int* in_sizes, int n_in, void* d_out, int out_size, void* d_ws, size_t ws_size, hipStream_t stream) {
    static int grid = 0;
    if (grid == 0) {
        if (n_in != 22 || out_size != NTOK * DM_ || ws_size < WS_END) { fprintf(stderr, "kernel_launch: unexpected problem (n_in %d, out %d, ws %zu); nothing launched\n", n_in, out_size, ws_size); grid = -1; return; }
        int dev = 0, cus = 0, per_cu = 0;
        if (hipGetDevice(&dev) != hipSuccess || hipDeviceGetAttribute(&cus, hipDeviceAttributeMultiprocessorCount, dev) != hipSuccess) { grid = -1; return; }
        if (hipFuncSetAttribute((const void*)hybrid_fwd, hipFuncAttributeMaxDynamicSharedMemorySize, LDS_BYTES) != hipSuccess) { fprintf(stderr, "kernel_launch: hipFuncSetAttribute failed\n"); grid = -1; return; }
        if (hipOccupancyMaxActiveBlocksPerMultiprocessor(&per_cu, (const void*)hybrid_fwd, NWAVES * 64, LDS_BYTES) != hipSuccess || per_cu < 1) { fprintf(stderr, "kernel_launch: occupancy query reports %d blocks per CU\n", per_cu); (void)hipGetLastError(); grid = -1; return; }
        grid = cus;
        if (grid != 256) { fprintf(stderr, "kernel_launch: built for a 256-CU device, found %d\n", cus); grid = -1; return; }
    }
    if (grid < 0) return;
    if (hipMemsetAsync((char*)d_ws + WS_CTL, 0, CTL_ZERO_BYTES, stream) != hipSuccess) return;
#ifdef XTRA_MEMSET
    for (int i = 0; i < XTRA_MEMSET; ++i) if (hipMemsetAsync((char*)d_ws + WS_CTL, 0, CTL_ZERO_BYTES, stream) != hipSuccess) return;
#endif
    Args a{};
    for (int i = 0; i < 22; ++i) a.in[i] = (const float*)d_in[i];
    a.out = (float*)d_out; a.ws = (unsigned char*)d_ws;
    hipLaunchKernelGGL(hybrid_fwd, dim3(grid), dim3(NWAVES * 64), LDS_BYTES, stream, a);
}
```
